# Optimizing an MI355X kernel written in HIP

```python
import math
import jax
import jax.numpy as jnp
from jax import lax
import numpy as np

D_MODEL = 1024
BATCH = 16
SEQ = 4096
DEPTH = 4

N_MIXERS = 3
N_A = (DEPTH + N_MIXERS - 1) // N_MIXERS
N_B = (DEPTH + N_MIXERS - 2) // N_MIXERS
N_C = (DEPTH + N_MIXERS - 3) // N_MIXERS
MEM_LEN = 256
DEEPNORM_ALPHA = (2 * DEPTH) ** 0.25
DEEPNORM_BETA = (8 * DEPTH) ** -0.25
NORM_EPS = 1e-5
ROPE_THETA = 10000.0
MAX_POS_OFFSET = 1024
MASK_VALUE = -1e30
MIN_FORGET = 1e-6

A_EXPAND = 128
A_HEADS = D_MODEL // A_EXPAND
A_HEAD_V = D_MODEL // A_HEADS
A_CHUNK = 64

B_GROUPS = ((128, 1), (512, 4), (2048, 16))
B_HEAD_DIM = 64
B_HEADS = D_MODEL // B_HEAD_DIM
B_BLOCK = 128

C_GROUP_CH = 16
C_GROUPS = D_MODEL // C_GROUP_CH
C_STATE = 64
DT_MIN = 1e-3
DT_MAX = 1e-1

M_HEADS = 4
M_HEAD_DIM = D_MODEL // M_HEADS

N_EXPERTS = 32
TOP_K = 4
D_EXPERT = D_MODEL
SWIGLU_ALPHA = 1.702
SWIGLU_LIMIT = 7.0
MOE_BLOCK = 128

kernel_name = 'hybrid_hgrn2_dilated_s5_moe_trunk'


def layer_norm(x, g, b):
    xf = x.astype(jnp.float32)
    mu = jnp.mean(xf, axis=-1, keepdims=True)
    var = jnp.mean(jnp.square(xf - mu), axis=-1, keepdims=True)
    return ((xf - mu) * lax.rsqrt(var + NORM_EPS) * g + b).astype(x.dtype)


def rms_norm(x, g):
    xf = x.astype(jnp.float32)
    y = xf * lax.rsqrt(jnp.mean(jnp.square(xf), axis=-1, keepdims=True) + NORM_EPS)
    return (y * g).astype(x.dtype)


def rope(x, positions):
    half = x.shape[-1] // 2
    inv_freq = ROPE_THETA ** (-jnp.arange(half, dtype=jnp.float32) / half)
    ang = positions.astype(jnp.float32)[..., None] * inv_freq
    cos, sin = jnp.cos(ang)[:, :, None, :], jnp.sin(ang)[:, :, None, :]
    xf = x.astype(jnp.float32)
    x1, x2 = xf[..., :half], xf[..., half:]
    return jnp.concatenate([x1 * cos - x2 * sin, x1 * sin + x2 * cos], axis=-1).astype(x.dtype)


def hgrn2_mixer(x, w_in, norm_g, w_out, lower_bound):
    bsz, seq, dm = x.shape
    n_chunks = seq // A_CHUNK
    q, f, i, g = jnp.split(x @ w_in, 4, axis=-1)
    q = jax.nn.silu(q.astype(jnp.float32))
    lb = lower_bound.astype(jnp.float32)
    fg = lb + (1.0 - lb) * jax.nn.sigmoid(f.astype(jnp.float32))
    log_f = jnp.log(jnp.maximum(fg, MIN_FORGET))
    k = 1.0 - fg

    def to_chunks(t):
        return t.reshape(bsz, n_chunks, A_CHUNK, A_HEADS, -1).transpose(1, 0, 3, 2, 4)

    qc, kc, vc = to_chunks(q), to_chunks(k), to_chunks(i.astype(jnp.float32))
    bc = jnp.cumsum(to_chunks(log_f), axis=3)
    causal = jnp.tril(jnp.ones((A_CHUNK, A_CHUNK), dtype=bool))[:, :, None]

    def chunk_step(state, inp):
        q_c, k_c, v_c, b_c = inp
        rel = b_c[:, :, :, None, :] - b_c[:, :, None, :, :]
        decay = jnp.where(causal, jnp.exp(jnp.where(causal, rel, 0.0)), 0.0)
        scores = jnp.einsum('bhtd,bhsd,bhtsd->bhts', q_c, k_c, decay)
        o = (jnp.einsum('bhts,bhsv->bhtv', scores, v_c)
             + jnp.einsum('bhtd,bhdv->bhtv', q_c * jnp.exp(b_c), state))
        b_end = b_c[:, :, -1:, :]
        new_state = (jnp.exp(b_end[:, :, 0, :, None]) * state
                     + jnp.einsum('bhsd,bhsv->bhdv', k_c * jnp.exp(b_end - b_c), v_c))
        return new_state, o

    state0 = jnp.zeros((bsz, A_HEADS, A_EXPAND, A_HEAD_V), jnp.float32)
    _, o = lax.scan(chunk_step, state0, (qc, kc, vc, bc))
    o = o.transpose(1, 0, 3, 2, 4).reshape(bsz, seq, A_HEADS, A_HEAD_V)
    o = rms_norm(o, norm_g.reshape(A_HEADS, A_HEAD_V))
    o = o * jax.nn.silu(g.astype(jnp.float32)).reshape(bsz, seq, A_HEADS, A_HEAD_V)
    return o.reshape(bsz, seq, dm).astype(x.dtype) @ w_out


def dilated_window_attention(q, k, v, window, dilation):
    bsz, seq, nh, dh = q.shape
    sub_len = seq // dilation
    reach = window // dilation
    sub_pad = -(-sub_len // B_BLOCK) * B_BLOCK
    nb = sub_pad // B_BLOCK
    z = bsz * dilation

    def to_blocks(t):
        t = t.reshape(bsz, sub_len, dilation, nh, dh).transpose(0, 2, 1, 3, 4).reshape(z, sub_len, nh, dh)
        t = jnp.pad(t, ((0, 0), (0, sub_pad - sub_len), (0, 0), (0, 0)))
        return t.reshape(z, nb, B_BLOCK, nh, dh)

    def with_prev(t):
        prev = jnp.pad(t, ((0, 0), (1, 0), (0, 0), (0, 0), (0, 0)))[:, :-1]
        return jnp.concatenate([prev, t], axis=2)

    qb = to_blocks(q)
    kk, vv = with_prev(to_blocks(k)), with_prev(to_blocks(v))
    scores = jnp.einsum('znqhd,znkhd->znhqk', qb, kk).astype(jnp.float32) * (dh ** -0.5)
    q_pos = jnp.arange(nb)[:, None] * B_BLOCK + jnp.arange(B_BLOCK)[None, :]
    k_pos = jnp.arange(nb)[:, None] * B_BLOCK - B_BLOCK + jnp.arange(2 * B_BLOCK)[None, :]
    dist = q_pos[:, :, None] - k_pos[:, None, :]
    valid = (dist >= 0) & (dist <= reach) & (k_pos[:, None, :] >= 0)
    scores = jnp.where(valid[None, :, None], scores, MASK_VALUE)
    lse = jax.nn.logsumexp(scores, axis=-1)
    p = jnp.exp(scores - lse[..., None])
    out = jnp.einsum('znhqk,znkhd->znqhd', p, vv.astype(jnp.float32))

    def from_blocks(t):
        tail = t.shape[3:]
        t = t.reshape(z, sub_pad, *tail)[:, :sub_len]
        t = t.reshape(bsz, dilation, sub_len, *tail)
        return jnp.swapaxes(t, 1, 2).reshape(bsz, seq, *tail)

    return from_blocks(out), from_blocks(jnp.swapaxes(lse, 2, 3)[..., None])[..., 0]


def dilated_mixer(x, positions, w_in, w_out):
    bsz, seq, dm = x.shape
    proj = (x @ w_in).reshape(bsz, seq, len(B_GROUPS), 3, B_HEADS, B_HEAD_DIM)
    outs, lses = [], []
    for gi, (window, dilation) in enumerate(B_GROUPS):
        q = rope(proj[:, :, gi, 0], positions)
        k = rope(proj[:, :, gi, 1], positions)
        o, l = dilated_window_attention(q, k, proj[:, :, gi, 2], window, dilation)
        outs.append(o)
        lses.append(l)
    wts = jax.nn.softmax(jnp.stack(lses, axis=0), axis=0)[..., None]
    o = jnp.sum(wts * jnp.stack(outs, axis=0), axis=0)
    return o.reshape(bsz, seq, dm).astype(x.dtype) @ w_out


def s5_mixer(x, a_re, a_im, log_dt, b_re, b_im, c_re, c_im, d_skip, w_glu):
    bsz, seq, dm = x.shape
    f32 = jnp.float32
    u = x.astype(f32).reshape(bsz, seq, C_GROUPS, C_GROUP_CH)
    ar, ai = a_re.astype(f32), a_im.astype(f32)
    dt = jnp.exp(log_dt.astype(f32))[:, None]
    mag = jnp.exp(ar * dt)
    lam_re, lam_im = mag * jnp.cos(ai * dt), mag * jnp.sin(ai * dt)
    den = ar * ar + ai * ai
    fr = ((lam_re - 1.0) * ar + lam_im * ai) / den
    fi = (lam_im * ar - (lam_re - 1.0) * ai) / den
    br, bi = b_re.astype(f32), b_im.astype(f32)
    bb_re = fr[..., None] * br - fi[..., None] * bi
    bb_im = fr[..., None] * bi + fi[..., None] * br
    bu_re = jnp.einsum('bsgc,gnc->bsgn', u, bb_re)
    bu_im = jnp.einsum('bsgc,gnc->bsgn', u, bb_im)
    la_re = jnp.broadcast_to(lam_re[None, None], (1, seq, C_GROUPS, C_STATE))
    la_im = jnp.broadcast_to(lam_im[None, None], (1, seq, C_GROUPS, C_STATE))

    def combine(left, right):
        a1r, a1i, b1r, b1i = left
        a2r, a2i, b2r, b2i = right
        return (a1r * a2r - a1i * a2i, a1r * a2i + a1i * a2r,
                a2r * b1r - a2i * b1i + b2r, a2r * b1i + a2i * b1r + b2i)

    _, _, xr, xi = lax.associative_scan(combine, (la_re, la_im, bu_re, bu_im), axis=1)
    y = (jnp.einsum('bsgn,gcn->bsgc', xr, c_re.astype(f32))
         - jnp.einsum('bsgn,gcn->bsgc', xi, c_im.astype(f32)))
    y = y.reshape(bsz, seq, dm) + d_skip.astype(f32) * x.astype(f32)
    h = jax.nn.gelu(y).astype(x.dtype) @ w_glu
    val, gate = jnp.split(h, 2, axis=-1)
    return (val * jax.nn.sigmoid(gate)).astype(x.dtype)


def memory_cross_attention(x, mem_k, mem_v, w_q, w_o):
    bsz, seq, dm = x.shape
    q = (x @ w_q).reshape(bsz, seq, M_HEADS, M_HEAD_DIM)
    s = jnp.einsum('bshd,bmhd->bhsm', q, mem_k).astype(jnp.float32) * (M_HEAD_DIM ** -0.5)
    p = jax.nn.softmax(s, axis=-1)
    o = jnp.einsum('bhsm,bmhd->bshd', p, mem_v.astype(jnp.float32))
    return o.reshape(bsz, seq, dm).astype(x.dtype) @ w_o


def clamped_swiglu(h):
    h_glu, h_lin = jnp.split(h, 2, axis=-1)
    h_glu = jnp.minimum(h_glu, SWIGLU_LIMIT)
    h_lin = jnp.clip(h_lin, -SWIGLU_LIMIT, SWIGLU_LIMIT)
    return h_glu * jax.nn.sigmoid(SWIGLU_ALPHA * h_glu) * (h_lin + 1.0)


def moe_ffn(x, w_r, b_r, w1, b1, w2, b2):
    bsz, seq, dm = x.shape
    n_tok = bsz * seq
    n_assign = n_tok * TOP_K
    xt = x.reshape(n_tok, dm)
    logits = (xt @ w_r + b_r).astype(jnp.float32)
    top_val, top_idx = lax.top_k(logits, TOP_K)
    gates = jax.nn.softmax(top_val, axis=-1)
    flat_e = top_idx.reshape(-1)
    order = jnp.argsort(flat_e)
    sorted_e = flat_e[order]
    tok = order // TOP_K
    counts = jnp.bincount(flat_e, length=N_EXPERTS)
    padded = (counts + MOE_BLOCK - 1) // MOE_BLOCK * MOE_BLOCK
    pad_end = jnp.cumsum(padded)
    slot = (pad_end - padded)[sorted_e] + (jnp.arange(n_assign) - (jnp.cumsum(counts) - counts)[sorted_e])
    n_blocks = -(-n_assign // MOE_BLOCK) + N_EXPERTS
    xs = jnp.zeros((n_blocks * MOE_BLOCK, dm), x.dtype).at[slot].set(xt[tok])
    block_e = jnp.minimum(jnp.searchsorted(pad_end, jnp.arange(n_blocks) * MOE_BLOCK, side='right'),
                          N_EXPERTS - 1)

    def expert_block(args):
        xb, e = args
        return clamped_swiglu(xb @ w1[e] + b1[e]) @ w2[e] + b2[e]

    ys = lax.map(expert_block, (xs.reshape(n_blocks, MOE_BLOCK, dm), block_e)).reshape(-1, dm)[slot]
    wts = gates.reshape(-1)[order][:, None].astype(ys.dtype)
    y = jnp.zeros_like(xt).at[tok].add(ys * wts)
    return y.reshape(bsz, seq, dm)


def setup_inputs(seed: int = 0) -> dict:
    key = jax.random.key(seed)
    ks = jax.random.split(key, 32)
    f32 = jnp.float32

    def nrm(k, shape, scale):
        return jax.random.normal(k, shape, f32) * scale

    d = D_MODEL
    s_in = d ** -0.5
    s_out = s_in * DEEPNORM_BETA
    positions = (jax.random.randint(ks[2], (BATCH, 1), 0, MAX_POS_OFFSET, dtype=jnp.int32)
                 + jnp.arange(SEQ, dtype=jnp.int32)[None, :])
    return {
        'x': nrm(ks[0], (BATCH, SEQ, d), 1.0),
        'mem': nrm(ks[1], (BATCH, MEM_LEN, d), 1.0),
        'positions': positions,
        'ln_g': 1.0 + nrm(ks[3], (DEPTH, 3, d), 0.02),
        'ln_b': nrm(ks[4], (DEPTH, 3, d), 0.02),
        'a_w_in': nrm(ks[5], (N_A, d, 4 * d), s_in),
        'a_lower_bounds': nrm(ks[6], (DEPTH, d), 0.1),
        'a_norm_g': 1.0 + nrm(ks[7], (N_A, d), 0.02),
        'a_w_out': nrm(ks[8], (N_A, d, d), s_out),
        'b_w_in': nrm(ks[9], (N_B, d, 3 * len(B_GROUPS) * d), s_in),
        'b_w_out': nrm(ks[10], (N_B, d, d), s_out),
        'c_a_re': -0.5 + nrm(ks[11], (N_C, C_GROUPS, C_STATE), 0.01),
        'c_a_im': math.pi * jnp.arange(C_STATE, dtype=f32) + nrm(ks[12], (N_C, C_GROUPS, C_STATE), 0.01),
        'c_log_dt': jax.random.uniform(ks[13], (N_C, C_GROUPS), f32, math.log(DT_MIN), math.log(DT_MAX)),
        'c_b_re': nrm(ks[14], (N_C, C_GROUPS, C_STATE, C_GROUP_CH), (2 * C_GROUP_CH) ** -0.5),
        'c_b_im': nrm(ks[15], (N_C, C_GROUPS, C_STATE, C_GROUP_CH), (2 * C_GROUP_CH) ** -0.5),
        'c_c_re': nrm(ks[16], (N_C, C_GROUPS, C_GROUP_CH, C_STATE), C_STATE ** -0.5),
        'c_c_im': nrm(ks[17], (N_C, C_GROUPS, C_GROUP_CH, C_STATE), C_STATE ** -0.5),
        'c_d': nrm(ks[18], (N_C, d), 0.5),
        'c_w_glu': jnp.concatenate([nrm(ks[19], (N_C, d, d), s_out), nrm(ks[20], (N_C, d, d), s_in)], axis=-1),
        'm_w_kv': nrm(ks[21], (d, 2 * d), s_in),
        'm_w_q': nrm(ks[22], (DEPTH, d, d), s_in),
        'm_w_o': nrm(ks[23], (DEPTH, d, d), s_out),
        'r_w': nrm(ks[24], (DEPTH, d, N_EXPERTS), s_in),
        'r_b': nrm(ks[25], (DEPTH, N_EXPERTS), 0.01),
        'e_w1': nrm(ks[26], (DEPTH, N_EXPERTS, d, 2 * D_EXPERT), s_in),
        'e_b1': nrm(ks[27], (DEPTH, N_EXPERTS, 2 * D_EXPERT), 0.01),
        'e_w2': nrm(ks[28], (DEPTH, N_EXPERTS, D_EXPERT, d), D_EXPERT ** -0.5 * DEEPNORM_BETA),
        'e_b2': nrm(ks[29], (DEPTH, N_EXPERTS, d), 0.01),
    }


def reference(x, mem, positions, ln_g, ln_b, a_w_in, a_lower_bounds, a_norm_g, a_w_out,
              b_w_in, b_w_out, c_a_re, c_a_im, c_log_dt, c_b_re, c_b_im, c_c_re, c_c_im,
              c_d, c_w_glu, m_w_kv, m_w_q, m_w_o, r_w, r_b, e_w1, e_b1, e_w2, e_b2):
    bsz, seq, dm = x.shape
    lb = jax.nn.softmax(a_lower_bounds.astype(jnp.float32), axis=0)
    lb = jnp.cumsum(lb, axis=0) - lb[0]
    mem_kv = (mem @ m_w_kv).reshape(bsz, mem.shape[1], 2, M_HEADS, M_HEAD_DIM)
    mem_k, mem_v = mem_kv[:, :, 0], mem_kv[:, :, 1]
    h = x
    for layer in range(DEPTH):
        kind, j = layer % N_MIXERS, layer // N_MIXERS
        if kind == 0:
            mix = hgrn2_mixer(h, a_w_in[j], a_norm_g[j], a_w_out[j], lb[layer])
        elif kind == 1:
            mix = dilated_mixer(h, positions, b_w_in[j], b_w_out[j])
        else:
            mix = s5_mixer(h, c_a_re[j], c_a_im[j], c_log_dt[j], c_b_re[j], c_b_im[j],
                           c_c_re[j], c_c_im[j], c_d[j], c_w_glu[j])
        h = layer_norm(DEEPNORM_ALPHA * h + mix, ln_g[layer, 0], ln_b[layer, 0])
        h = layer_norm(DEEPNORM_ALPHA * h + memory_cross_attention(h, mem_k, mem_v, m_w_q[layer], m_w_o[layer]),
                       ln_g[layer, 1], ln_b[layer, 1])
        h = layer_norm(DEEPNORM_ALPHA * h + moe_ffn(h, r_w[layer], r_b[layer], e_w1[layer], e_b1[layer],
                                                    e_w2[layer], e_b2[layer]),
                       ln_g[layer, 2], ln_b[layer, 2])
    return h
```

```cpp
#include <hip/hip_runtime.h>
#include <cstdio>
#include <cstdint>
namespace pg8 {
#define PG8_LAS __attribute__((address_space(3)))
typedef unsigned short bf16_t;
typedef short bf16x8 __attribute__((ext_vector_type(8)));
typedef float f32x4 __attribute__((ext_vector_type(4)));
typedef int i32x4 __attribute__((ext_vector_type(4)));
typedef unsigned u32x4 __attribute__((ext_vector_type(4)));
constexpr int BM = 256, BK = 64, HALF = 128, HTB = HALF * BK * 2  , STAGE_BYTES = 8 * HTB, NXCD = 8, WGM = 8;

__host__ __device__ __forceinline__ int lds_byte(int r, int c) { const int st = (r >> 4) * 2 + (c >> 5), rr = r & 15, cc = c & 31, ob = rr * 64 + cc * 2; return st * 1024 + (ob ^ (((ob >> 9) & 1) << 5)); }
__host__ __device__ __forceinline__ void stage_rc(int b, int& R, int& C) { const int st = b / 1024, sb = b % 1024, swz = sb ^ (((sb >> 9) & 1) << 5); R = (st >> 1) * 16 + swz / 64; C = (st & 1) * 32 + (swz % 64) / 2; }
__host__ __device__ __forceinline__ int perm32(int rho) { const int n = rho >> 4, i = rho & 15; return 8 * (i >> 2) + 4 * n + (i & 3); }

struct Unit { int pm, pn; };
struct Gemm { const bf16_t* A; const bf16_t* Bt; int M, N, K; };

struct StaticOrder {
    int nM, nN, nwg, G, c;
    __host__ __device__ void init(int M, int N, int G_, int c_) { nM = M / BM; nN = N / BM; nwg = nM * nN; G = G_; c = c_; }
    __host__ __device__ bool next(int i, Unit& u) const {
        const long L = (long)i * G + c; if (L >= nwg) return false;
        int wgid = (int)L; { const int q = nwg / NXCD, r = nwg % NXCD, xcd = wgid % NXCD, off = wgid / NXCD; wgid = (xcd < r ? xcd * (q + 1) : r * (q + 1) + (xcd - r) * q) + off; }
        const int nig = WGM * nN, gid = wgid / nig, fm = gid * WGM, gsz = (nM - fm) < WGM ? (nM - fm) : WGM;
        u.pm = fm + ((wgid % nig) % gsz); u.pn = (wgid % nig) / gsz; return true;
    }
    __device__ __forceinline__ void a_ready(const Unit&) const {}
    __device__ __forceinline__ void done(const Unit&) const {}
};

typedef float cvt_f32x2 __attribute__((ext_vector_type(2)));
typedef __bf16 cvt_bf16x2 __attribute__((ext_vector_type(2)));
__device__ __forceinline__ unsigned cvt_pk_bf16(float lo, float hi) { const cvt_f32x2 v = {lo, hi}; const cvt_bf16x2 r = __builtin_convertvector(v, cvt_bf16x2); return __builtin_bit_cast(unsigned, r); }
template <class Epi, class Sched, bool ALIGN_EPI = false, bool SP2 = false, bool FP8 = false>
__device__ __forceinline__ void gemm_phase(PG8_LAS unsigned char* lds, const Gemm g, const Sched& S, const Epi& E) {
    int tid_ = threadIdx.x; asm volatile("" : "+v"(tid_)); const int tid = tid_, wid = __builtin_amdgcn_readfirstlane(tid >> 6), lane = tid & 63, wr = wid >> 2, wc = wid & 3, fr = lane & 15, fq = lane >> 4;
    const int K = g.K, nt = K / BK;
    unsigned voffA[2], voffB[2];
#pragma unroll
    for (int i = 0; i < 2; ++i) { int R, C; stage_rc(tid * 16 + i * 8192, R, C); const int Rb = Epi::PERM ? ((R & ~31) + perm32(R & 31)) : R;
        voffA[i] = (unsigned)(R * K + C) * 2u; voffB[i] = (unsigned)(Rb * K + C) * 2u; }
    const size_t kstep = (size_t)(BK * 2);
    const size_t hstep = (size_t)HALF * K * 2;
    const size_t tstep = 2 * hstep;
    const unsigned ldsw = (unsigned)wid * 1024u;
    const int aoff = lds_byte(wr * 64 + fr, fq * 8), boff = lds_byte(wc * 32 + fr, fq * 8);
#define PG8_SA(b, h) (((b) * 2 + (h)) * HTB)
#define PG8_SB(b, h) ((4 + (b) * 2 + (h)) * HTB)
#define PG8_STAGE(bufoff, gbase, voff) do { _Pragma("unroll") for (int _i = 0; _i < 2; ++_i) \
        __builtin_amdgcn_global_load_lds((const unsigned*)((const char*)(gbase) + (voff)[_i]), (PG8_LAS unsigned*)(lds + (bufoff) + ldsw + _i * 8192), 16, 0, 0); } while (0)
#define PG8_LDA(dst, b, h) do { _Pragma("unroll") for (int m = 0; m < 4; ++m) _Pragma("unroll") for (int k = 0; k < 2; ++k) dst[m][k] = *(const PG8_LAS bf16x8*)(lds + PG8_SA(b, h) + aoff + m * 2048 + k * 1024); } while (0)
#define PG8_LDB(dst, b, h) do { _Pragma("unroll") for (int n = 0; n < 2; ++n) _Pragma("unroll") for (int k = 0; k < 2; ++k) dst[n][k] = *(const PG8_LAS bf16x8*)(lds + PG8_SB(b, h) + boff + n * 2048 + k * 1024); } while (0)
#define PG8_MMA(ai, bj, At, Bt) do { __builtin_amdgcn_s_setprio(1); _Pragma("unroll") for (int m = 0; m < 4; ++m) _Pragma("unroll") for (int n = 0; n < 2; ++n) { \
        if constexpr (FP8) acc[ai][bj][m][n] = __builtin_amdgcn_mfma_scale_f32_16x16x128_f8f6f4( \
            __builtin_shufflevector(__builtin_bit_cast(i32x4, Bt[n][0]), __builtin_bit_cast(i32x4, Bt[n][1]), 0, 1, 2, 3, 4, 5, 6, 7), \
            __builtin_shufflevector(__builtin_bit_cast(i32x4, At[m][0]), __builtin_bit_cast(i32x4, At[m][1]), 0, 1, 2, 3, 4, 5, 6, 7), acc[ai][bj][m][n], 0, 0, 0, 121, 0, 127); \
        else { _Pragma("unroll") for (int k = 0; k < 2; ++k) acc[ai][bj][m][n] = __builtin_amdgcn_mfma_f32_16x16x32_bf16(Bt[n][k], At[m][k], acc[ai][bj][m][n], 0, 0, 0); } } \
        if constexpr (FP8) { _Pragma("unroll") for (int m = 0; m < 4; ++m) _Pragma("unroll") for (int n = 0; n < 2; ++n) asm volatile("" : "+v"(acc[ai][bj][m][n]) :: "memory"); }     \
        __builtin_amdgcn_s_setprio(0); } while (0)
#define PG8_WAIT_V(n) asm volatile("s_waitcnt vmcnt(" #n ")" ::: "memory")
#define PG8_WAIT_L(n) asm volatile("s_waitcnt lgkmcnt(" #n ")" ::: "memory")
#define PG8_BAR __builtin_amdgcn_s_barrier()
#define PG8_SCHED __builtin_amdgcn_sched_barrier(0)
    Unit cur, nxt; int ui = 0;
    if (!S.next(0, cur)) return;
    f32x4 acc[2][2][4][2];
#pragma unroll
    for (int a = 0; a < 2; ++a)
#pragma unroll
        for (int b = 0; b < 2; ++b)
#pragma unroll
            for (int m = 0; m < 4; ++m)
#pragma unroll
                for (int n = 0; n < 2; ++n) acc[a][b][m][n] = (f32x4){0.f, 0.f, 0.f, 0.f};
    bf16x8 At[4][2], B0[2][2], B1[2][2];
    const char* cA = (const char*)g.A + (size_t)cur.pm * tstep; const char* cB = (const char*)g.Bt + (size_t)cur.pn * tstep;
    S.a_ready(cur);
    if constexpr (SP2) {
        PG8_STAGE(PG8_SB(0, 0), cB, voffB); PG8_STAGE(PG8_SB(0, 1), cB + hstep, voffB); PG8_STAGE(PG8_SA(0, 0), cA, voffA); PG8_STAGE(PG8_SA(0, 1), cA + hstep, voffA);
        if (wr == 1) PG8_BAR;
        PG8_WAIT_V(2); PG8_BAR;
        PG8_STAGE(PG8_SB(1, 0), cB + kstep, voffB); PG8_STAGE(PG8_SA(1, 0), cA + kstep, voffA); PG8_STAGE(PG8_SB(1, 1), cB + hstep + kstep, voffB);
        PG8_WAIT_V(6); PG8_BAR;
    } else {
        PG8_STAGE(PG8_SB(0, 0), cB, voffB); PG8_STAGE(PG8_SA(0, 0), cA, voffA); PG8_STAGE(PG8_SB(0, 1), cB + hstep, voffB); PG8_STAGE(PG8_SA(0, 1), cA + hstep, voffA);
        if (wr == 1) PG8_BAR;
        PG8_WAIT_V(4); PG8_BAR;
        PG8_STAGE(PG8_SB(1, 0), cB + kstep, voffB); PG8_STAGE(PG8_SA(1, 0), cA + kstep, voffA); PG8_STAGE(PG8_SB(1, 1), cB + hstep + kstep, voffB);
        PG8_WAIT_V(6); PG8_BAR;
    }
    for (;;) {
        const bool has_next = S.next(ui + 1, nxt);
        const char* nA = has_next ? (const char*)g.A + (size_t)nxt.pm * tstep : cA; const char* nB = has_next ? (const char*)g.Bt + (size_t)nxt.pn * tstep : cB;
        for (int t = 0; t < nt; t += 2) {
            const bool last = (t == nt - 2);
            const char* a1 = cA + (size_t)(t + 1) * kstep;
            const char* a2 = last ? nA : cA + (size_t)(t + 2) * kstep; const char* b2 = last ? nB : cB + (size_t)(t + 2) * kstep;
            const char* a3 = a2 + kstep; const char* b3 = b2 + kstep;
            if (last && has_next) S.a_ready(nxt);
            if constexpr (SP2) {
            PG8_LDB(B0, 0, 0); PG8_LDB(B1, 0, 1); PG8_SCHED; PG8_LDA(At, 0, 0); PG8_STAGE(PG8_SA(1, 1), a1 + hstep, voffA);
            PG8_WAIT_V(8); PG8_WAIT_L(0); PG8_BAR; PG8_MMA(0, 0, At, B0); PG8_MMA(0, 1, At, B1); PG8_BAR; PG8_SCHED;
            PG8_LDA(At, 0, 1); PG8_STAGE(PG8_SB(0, 0), b2, voffB); PG8_STAGE(PG8_SB(0, 1), b2 + hstep, voffB); PG8_STAGE(PG8_SA(0, 0), a2, voffA);
            PG8_WAIT_V(8); PG8_WAIT_L(0); PG8_BAR; PG8_MMA(1, 0, At, B0); PG8_MMA(1, 1, At, B1); PG8_BAR; PG8_SCHED;
            PG8_LDB(B0, 1, 0); PG8_LDB(B1, 1, 1); PG8_SCHED; PG8_LDA(At, 1, 0); PG8_STAGE(PG8_SA(0, 1), a2 + hstep, voffA);
            PG8_WAIT_V(8); PG8_WAIT_L(0); PG8_BAR; PG8_MMA(0, 0, At, B0); PG8_MMA(0, 1, At, B1); PG8_BAR; PG8_SCHED;
            PG8_LDA(At, 1, 1); PG8_STAGE(PG8_SB(1, 0), b3, voffB); PG8_STAGE(PG8_SB(1, 1), b3 + hstep, voffB); PG8_STAGE(PG8_SA(1, 0), a3, voffA);
            PG8_WAIT_V(8); PG8_WAIT_L(0); PG8_BAR; PG8_MMA(1, 0, At, B0); PG8_MMA(1, 1, At, B1); PG8_BAR; PG8_SCHED;
            } else {
            PG8_LDB(B0, 0, 0); PG8_SCHED; PG8_LDA(At, 0, 0); PG8_STAGE(PG8_SA(1, 1), a1 + hstep, voffA);
            PG8_WAIT_L(8); PG8_BAR; PG8_WAIT_L(0); PG8_MMA(0, 0, At, B0); PG8_BAR; PG8_SCHED;
            PG8_LDB(B1, 0, 1); PG8_STAGE(PG8_SB(0, 0), b2, voffB);
            PG8_BAR; PG8_WAIT_L(0); PG8_MMA(0, 1, At, B1); PG8_BAR;
            PG8_LDA(At, 0, 1); PG8_STAGE(PG8_SA(0, 0), a2, voffA);
            PG8_BAR; PG8_WAIT_L(0); PG8_MMA(1, 0, At, B0); PG8_BAR; PG8_SCHED;
            PG8_STAGE(PG8_SB(0, 1), b2 + hstep, voffB);
            PG8_WAIT_V(6); PG8_BAR; PG8_MMA(1, 1, At, B1); PG8_BAR;
            PG8_LDB(B0, 1, 0); PG8_SCHED; PG8_LDA(At, 1, 0); PG8_STAGE(PG8_SA(0, 1), a2 + hstep, voffA);
            PG8_WAIT_L(8); PG8_BAR; PG8_WAIT_L(0); PG8_MMA(0, 0, At, B0); PG8_BAR; PG8_SCHED;
            PG8_LDB(B1, 1, 1); PG8_STAGE(PG8_SB(1, 0), b3, voffB);
            PG8_BAR; PG8_WAIT_L(0); PG8_MMA(0, 1, At, B1); PG8_BAR;
            PG8_LDA(At, 1, 1); PG8_STAGE(PG8_SA(1, 0), a3, voffA);
            PG8_BAR; PG8_WAIT_L(0); PG8_MMA(1, 0, At, B0); PG8_BAR; PG8_SCHED;
            PG8_STAGE(PG8_SB(1, 1), b3 + hstep, voffB);
            PG8_WAIT_V(6); PG8_BAR; PG8_MMA(1, 1, At, B1); PG8_BAR;
            }
        }
        if constexpr (ALIGN_EPI) { if (wr == 0) PG8_BAR; }
        if constexpr (!Epi::AFTER_DRAIN) { E(acc, cur, wr, wc, fr, fq); S.done(cur); }
        if (!has_next) break;
#pragma unroll
        for (int a = 0; a < 2; ++a)
#pragma unroll
            for (int b = 0; b < 2; ++b)
#pragma unroll
                for (int m = 0; m < 4; ++m)
#pragma unroll
                    for (int n = 0; n < 2; ++n) acc[a][b][m][n] = (f32x4){0.f, 0.f, 0.f, 0.f};
        cur = nxt; cA = nA; cB = nB; ++ui;
        if constexpr (ALIGN_EPI) { if (wr == 1) PG8_BAR; }
    }
    PG8_WAIT_V(0);
    if constexpr (!ALIGN_EPI) { if (wr == 0) PG8_BAR; }
    PG8_BAR;
    if constexpr (Epi::AFTER_DRAIN) { E.fused(acc, cur, wr, wc, fr, fq, lds, wid, lane); S.done(cur); }
#undef PG8_SA
#undef PG8_SB
#undef PG8_STAGE
#undef PG8_LDA
#undef PG8_LDB
#undef PG8_MMA
#undef PG8_WAIT_V
#undef PG8_WAIT_L
#undef PG8_BAR
#undef PG8_SCHED
}

template <class Epi, class Sched, bool ALIGN_EPI = true, bool SP2 = true, bool FP8 = false>
__device__ __forceinline__ void gemm_phase_gather(PG8_LAS unsigned char* lds, const Gemm g, const Sched& S, const Epi& E) {
    int tid_ = threadIdx.x; asm volatile("" : "+v"(tid_)); const int tid = tid_, wid = __builtin_amdgcn_readfirstlane(tid >> 6), lane = tid & 63, wr = wid >> 2, wc = wid & 3, fr = lane & 15, fq = lane >> 4;
    const int K = g.K, nt = K / BK;
    unsigned voffA[2], voffB[2]; int rA[2];
#pragma unroll
    for (int i = 0; i < 2; ++i) { int R, C; stage_rc(tid * 16 + i * 8192, R, C); const int Rb = Epi::PERM ? ((R & ~31) + perm32(R & 31)) : R;
        voffA[i] = (unsigned)C * 2u; voffB[i] = (unsigned)(Rb * K + C) * 2u; rA[i] = R; }
    const size_t kstep = (size_t)(BK * 2);
    const size_t hstep = (size_t)HALF * K * 2;
    const size_t tstep = 2 * hstep;
    const unsigned ldsw = (unsigned)wid * 1024u;
    const int aoff = lds_byte(wr * 64 + fr, fq * 8), boff = lds_byte(wc * 32 + fr, fq * 8);
#define PG8_SA(b, h) (((b) * 2 + (h)) * HTB)
#define PG8_SB(b, h) ((4 + (b) * 2 + (h)) * HTB)
#define PG8_STAGE(bufoff, gbase, voff) do { _Pragma("unroll") for (int _i = 0; _i < 2; ++_i) \
        __builtin_amdgcn_global_load_lds((const unsigned*)((const char*)(gbase) + (voff)[_i]), (PG8_LAS unsigned*)(lds + (bufoff) + ldsw + _i * 8192), 16, 0, 0); } while (0)
#define PG8_STAGE_A(b, h, kptr, offs) do { _Pragma("unroll") for (int _i = 0; _i < 2; ++_i) \
        __builtin_amdgcn_global_load_lds((const unsigned*)((const char*)(kptr) + (offs)[h][_i]), (PG8_LAS unsigned*)(lds + PG8_SA(b, h) + ldsw + _i * 8192), 16, 0, 0); } while (0)
#define PG8_GOFFS(dst, k_) do { _Pragma("unroll") for (int h_ = 0; h_ < 2; ++h_) _Pragma("unroll") for (int _i = 0; _i < 2; ++_i) \
        dst[h_][_i] = (unsigned)S.rowidx[(k_) * 256 + h_ * HALF + rA[_i]] * S.rowpitch + voffA[_i]; } while (0)
#define PG8_LDA(dst, b, h) do { _Pragma("unroll") for (int m = 0; m < 4; ++m) _Pragma("unroll") for (int k = 0; k < 2; ++k) dst[m][k] = *(const PG8_LAS bf16x8*)(lds + PG8_SA(b, h) + aoff + m * 2048 + k * 1024); } while (0)
#define PG8_LDB(dst, b, h) do { _Pragma("unroll") for (int n = 0; n < 2; ++n) _Pragma("unroll") for (int k = 0; k < 2; ++k) dst[n][k] = *(const PG8_LAS bf16x8*)(lds + PG8_SB(b, h) + boff + n * 2048 + k * 1024); } while (0)
#define PG8_MMA(ai, bj, At, Bt) do { __builtin_amdgcn_s_setprio(1); _Pragma("unroll") for (int m = 0; m < 4; ++m) _Pragma("unroll") for (int n = 0; n < 2; ++n) { \
        if constexpr (FP8) acc[ai][bj][m][n] = __builtin_amdgcn_mfma_scale_f32_16x16x128_f8f6f4( \
            __builtin_shufflevector(__builtin_bit_cast(i32x4, Bt[n][0]), __builtin_bit_cast(i32x4, Bt[n][1]), 0, 1, 2, 3, 4, 5, 6, 7), \
            __builtin_shufflevector(__builtin_bit_cast(i32x4, At[m][0]), __builtin_bit_cast(i32x4, At[m][1]), 0, 1, 2, 3, 4, 5, 6, 7), acc[ai][bj][m][n], 0, 0, 0, 121, 0, 127); \
        else { _Pragma("unroll") for (int k = 0; k < 2; ++k) acc[ai][bj][m][n] = __builtin_amdgcn_mfma_f32_16x16x32_bf16(Bt[n][k], At[m][k], acc[ai][bj][m][n], 0, 0, 0); } } \
        if constexpr (FP8) { _Pragma("unroll") for (int m = 0; m < 4; ++m) _Pragma("unroll") for (int n = 0; n < 2; ++n) asm volatile("" : "+v"(acc[ai][bj][m][n]) :: "memory"); }     \
        __builtin_amdgcn_s_setprio(0); } while (0)
#define PG8_WAIT_V(n) asm volatile("s_waitcnt vmcnt(" #n ")" ::: "memory")
#define PG8_WAIT_L(n) asm volatile("s_waitcnt lgkmcnt(" #n ")" ::: "memory")
#define PG8_BAR __builtin_amdgcn_s_barrier()
#define PG8_SCHED __builtin_amdgcn_sched_barrier(0)
    Unit cur, nxt; int ui = 0;
    if (!S.next(0, cur)) return;
    f32x4 acc[2][2][4][2];
#pragma unroll
    for (int a = 0; a < 2; ++a)
#pragma unroll
        for (int b = 0; b < 2; ++b)
#pragma unroll
            for (int m = 0; m < 4; ++m)
#pragma unroll
                for (int n = 0; n < 2; ++n) acc[a][b][m][n] = (f32x4){0.f, 0.f, 0.f, 0.f};
    bf16x8 At[4][2], B0[2][2], B1[2][2];
    const char* cA = (const char*)g.A; unsigned gA[2][2], gN[2][2]; PG8_GOFFS(gA, 0);
    typename Epi::State est; E.pre(cur, wc, fq, est);
    const char* cB = (const char*)g.Bt + (size_t)cur.pn * tstep;
    S.a_ready(cur);
    if constexpr (SP2) {
        PG8_STAGE(PG8_SB(0, 0), cB, voffB); PG8_STAGE(PG8_SB(0, 1), cB + hstep, voffB); PG8_STAGE_A(0, 0, cA, gA); PG8_STAGE_A(0, 1, cA, gA);
        if (wr == 1) PG8_BAR;
        PG8_WAIT_V(2); PG8_BAR;
        PG8_STAGE(PG8_SB(1, 0), cB + kstep, voffB); PG8_STAGE_A(1, 0, cA + kstep, gA); PG8_STAGE(PG8_SB(1, 1), cB + hstep + kstep, voffB);
        PG8_WAIT_V(6); PG8_BAR;
    } else {
        PG8_STAGE(PG8_SB(0, 0), cB, voffB); PG8_STAGE_A(0, 0, cA, gA); PG8_STAGE(PG8_SB(0, 1), cB + hstep, voffB); PG8_STAGE_A(0, 1, cA, gA);
        if (wr == 1) PG8_BAR;
        PG8_WAIT_V(4); PG8_BAR;
        PG8_STAGE(PG8_SB(1, 0), cB + kstep, voffB); PG8_STAGE_A(1, 0, cA + kstep, gA); PG8_STAGE(PG8_SB(1, 1), cB + hstep + kstep, voffB);
        PG8_WAIT_V(6); PG8_BAR;
    }
    for (;;) {
        const bool has_next = S.next(ui + 1, nxt);
        const char* nA = (const char*)g.A; if (has_next) PG8_GOFFS(gN, ui + 1); else { _Pragma("unroll") for (int h_ = 0; h_ < 2; ++h_) _Pragma("unroll") for (int _i = 0; _i < 2; ++_i) gN[h_][_i] = gA[h_][_i]; }
        const char* nB = has_next ? (const char*)g.Bt + (size_t)nxt.pn * tstep : cB;
        for (int t = 0; t < nt; t += 2) {
            const bool last = (t == nt - 2);
            const char* a1 = cA + (size_t)(t + 1) * kstep;
            const char* a2 = last ? nA : cA + (size_t)(t + 2) * kstep; const char* b2 = last ? nB : cB + (size_t)(t + 2) * kstep;
            const char* a3 = a2 + kstep; const char* b3 = b2 + kstep;
            unsigned g2[2][2]; _Pragma("unroll") for (int h_ = 0; h_ < 2; ++h_) _Pragma("unroll") for (int _i = 0; _i < 2; ++_i) g2[h_][_i] = last ? gN[h_][_i] : gA[h_][_i];
            if (last && has_next) S.a_ready(nxt);
            if constexpr (SP2) {
            PG8_LDB(B0, 0, 0); PG8_LDB(B1, 0, 1); PG8_SCHED; PG8_LDA(At, 0, 0); PG8_STAGE_A(1, 1, a1, gA);
            PG8_WAIT_V(8); PG8_WAIT_L(0); PG8_BAR; PG8_MMA(0, 0, At, B0); PG8_MMA(0, 1, At, B1); PG8_BAR; PG8_SCHED;
            PG8_LDA(At, 0, 1); PG8_STAGE(PG8_SB(0, 0), b2, voffB); PG8_STAGE(PG8_SB(0, 1), b2 + hstep, voffB); PG8_STAGE_A(0, 0, a2, g2);
            PG8_WAIT_V(8); PG8_WAIT_L(0); PG8_BAR; PG8_MMA(1, 0, At, B0); PG8_MMA(1, 1, At, B1); PG8_BAR; PG8_SCHED;
            PG8_LDB(B0, 1, 0); PG8_LDB(B1, 1, 1); PG8_SCHED; PG8_LDA(At, 1, 0); PG8_STAGE_A(0, 1, a2, g2);
            PG8_WAIT_V(8); PG8_WAIT_L(0); PG8_BAR; PG8_MMA(0, 0, At, B0); PG8_MMA(0, 1, At, B1); PG8_BAR; PG8_SCHED;
            PG8_LDA(At, 1, 1); PG8_STAGE(PG8_SB(1, 0), b3, voffB); PG8_STAGE(PG8_SB(1, 1), b3 + hstep, voffB); PG8_STAGE_A(1, 0, a3, g2);
            PG8_WAIT_V(8); PG8_WAIT_L(0); PG8_BAR; PG8_MMA(1, 0, At, B0); PG8_MMA(1, 1, At, B1); PG8_BAR; PG8_SCHED;
            } else {
            PG8_LDB(B0, 0, 0); PG8_SCHED; PG8_LDA(At, 0, 0); PG8_STAGE_A(1, 1, a1, gA);
            PG8_WAIT_L(8); PG8_BAR; PG8_WAIT_L(0); PG8_MMA(0, 0, At, B0); PG8_BAR; PG8_SCHED;
            PG8_LDB(B1, 0, 1); PG8_STAGE(PG8_SB(0, 0), b2, voffB);
            PG8_BAR; PG8_WAIT_L(0); PG8_MMA(0, 1, At, B1); PG8_BAR;
            PG8_LDA(At, 0, 1); PG8_STAGE_A(0, 0, a2, g2);
            PG8_BAR; PG8_WAIT_L(0); PG8_MMA(1, 0, At, B0); PG8_BAR; PG8_SCHED;
            PG8_STAGE(PG8_SB(0, 1), b2 + hstep, voffB);
            PG8_WAIT_V(6); PG8_BAR; PG8_MMA(1, 1, At, B1); PG8_BAR;
            PG8_LDB(B0, 1, 0); PG8_SCHED; PG8_LDA(At, 1, 0); PG8_STAGE_A(0, 1, a2, g2);
            PG8_WAIT_L(8); PG8_BAR; PG8_WAIT_L(0); PG8_MMA(0, 0, At, B0); PG8_BAR; PG8_SCHED;
            PG8_LDB(B1, 1, 1); PG8_STAGE(PG8_SB(1, 0), b3, voffB);
            PG8_BAR; PG8_WAIT_L(0); PG8_MMA(0, 1, At, B1); PG8_BAR;
            PG8_LDA(At, 1, 1); PG8_STAGE_A(1, 0, a3, g2);
            PG8_BAR; PG8_WAIT_L(0); PG8_MMA(1, 0, At, B0); PG8_BAR; PG8_SCHED;
            PG8_STAGE(PG8_SB(1, 1), b3 + hstep, voffB);
            PG8_WAIT_V(6); PG8_BAR; PG8_MMA(1, 1, At, B1); PG8_BAR;
            }
        }
        if constexpr (ALIGN_EPI) { if (wr == 0) PG8_BAR; }
        if constexpr (!Epi::AFTER_DRAIN) { E(acc, cur, wr, wc, fr, fq, est); S.done(cur); }
        if (!has_next) break;
#pragma unroll
        for (int a = 0; a < 2; ++a)
#pragma unroll
            for (int b = 0; b < 2; ++b)
#pragma unroll
                for (int m = 0; m < 4; ++m)
#pragma unroll
                    for (int n = 0; n < 2; ++n) acc[a][b][m][n] = (f32x4){0.f, 0.f, 0.f, 0.f};
        cur = nxt; cA = nA; cB = nB; ++ui; _Pragma("unroll") for (int h_ = 0; h_ < 2; ++h_) _Pragma("unroll") for (int _i = 0; _i < 2; ++_i) gA[h_][_i] = gN[h_][_i]; E.pre(cur, wc, fq, est);
        if constexpr (ALIGN_EPI) { if (wr == 1) PG8_BAR; }
    }
    PG8_WAIT_V(0);
    if constexpr (!ALIGN_EPI) { if (wr == 0) PG8_BAR; }
    PG8_BAR;
    if constexpr (Epi::AFTER_DRAIN) { E.fused(acc, cur, wr, wc, fr, fq, lds, wid, lane); S.done(cur); }
#undef PG8_SA
#undef PG8_SB
#undef PG8_STAGE
#undef PG8_STAGE_A
#undef PG8_GOFFS
#undef PG8_LDA
#undef PG8_LDB
#undef PG8_MMA
#undef PG8_WAIT_V
#undef PG8_WAIT_L
#undef PG8_BAR
#undef PG8_SCHED
}
}
#define XB_TMO      128
#define XB_XCNT(j)  (256  + 64 * (j))
#define XB_XSUB(j)  (1280 + 64 * (j))
#define XB_XGEN(j)  (2304 + 64 * (j))
#define XB_TOP      3328
#define XB_TOPGEN   3392
#define XCD_BAR_WORDS 3456
#define XB_SPIN_CAP (1u << 22)
#define LAS __attribute__((address_space(3)))

__device__ __forceinline__ unsigned xb_ld(unsigned* p)              { return __hip_atomic_load(p, __ATOMIC_RELAXED, __HIP_MEMORY_SCOPE_AGENT); }
__device__ __forceinline__ unsigned xb_add(unsigned* p, unsigned v) { return __hip_atomic_fetch_add(p, v, __ATOMIC_RELAXED, __HIP_MEMORY_SCOPE_AGENT); }
__device__ __forceinline__ unsigned xb_xcc_id() { return (unsigned)__builtin_amdgcn_s_getreg((3 << 11) | 20) & 0xFu; }
#define XB_SPIN(cond, bar) do { unsigned _sp = 0; while (cond) { __builtin_amdgcn_s_sleep(1); \
    if ((++_sp & 255u) == 0u) { if (xb_ld(&(bar)[XB_TMO])) break; if (_sp > XB_SPIN_CAP) { atomicAdd(&(bar)[XB_TMO], 1u); break; } } } } while (0)

struct XcdBarrier {
    unsigned* bar; unsigned x;
    volatile LAS unsigned* st;
};

__device__ __forceinline__ XcdBarrier xcd_barrier_post(unsigned* bar, volatile LAS unsigned* st) {
    XcdBarrier b; b.bar = bar; b.x = xb_xcc_id(); b.st = st;
    if (threadIdx.x == 0) (void)xb_add(&bar[XB_XCNT(b.x)], 1u);
    return b;
}
__device__ __forceinline__ void xcd_barrier_complete(unsigned* bar, unsigned x, unsigned& nloc, unsigned& nx) {
    const unsigned G = gridDim.x * gridDim.y * gridDim.z;
    unsigned sum, cnt, mine, sp = 0u;
    for (;;) {
        sum = 0u; cnt = 0u; mine = 0u;
#pragma unroll
        for (unsigned j = 0; j < 16; ++j) { const unsigned c = xb_ld(&bar[XB_XCNT(j)]); sum += c; cnt += (c > 0u) ? 1u : 0u; mine = (j == x) ? c : mine; }
        if (sum == G) break;
        __builtin_amdgcn_s_sleep(1);
        if ((++sp & 255u) == 0u) { if (xb_ld(&bar[XB_TMO])) break; if (sp > XB_SPIN_CAP) { atomicAdd(&bar[XB_TMO], 1u); break; } }
    }
    nloc = mine > 0u ? mine : 1u; nx = cnt > 0u ? cnt : 1u;
}

__device__ __forceinline__ bool l_tid0() { int t = threadIdx.x; asm volatile("" : "+v"(t)); return t == 0; }
__device__ __forceinline__ void xcd_barrier(const XcdBarrier& b) {
    asm volatile("s_waitcnt vmcnt(0)" ::: "memory");
    __syncthreads();
    if (l_tid0()) {
        unsigned* bar = b.bar;
        __builtin_amdgcn_s_waitcnt(0);
        unsigned nloc = b.st[0], nx = b.st[1];
        if (nloc == 0u) { xcd_barrier_complete(bar, b.x, nloc, nx); b.st[0] = nloc; b.st[1] = nx; }
        const unsigned old = xb_add(&bar[XB_XSUB(b.x)], 1u);
        const unsigned gen = old / nloc;
        if (old + 1u == (gen + 1u) * nloc) {
            __builtin_amdgcn_fence(__ATOMIC_RELEASE, "agent");
            asm volatile("s_waitcnt vmcnt(0)" ::: "memory");
            const unsigned og = xb_add(&bar[XB_TOP], 1u);
            const unsigned tg = og / nx;
            if (og + 1u == (tg + 1u) * nx) xb_add(&bar[XB_TOPGEN], 1u);
            else XB_SPIN(xb_ld(&bar[XB_TOPGEN]) == tg, bar);
            __builtin_amdgcn_fence(__ATOMIC_ACQUIRE, "agent");
            xb_add(&bar[XB_XGEN(b.x)], 1u);
            asm volatile("s_waitcnt vmcnt(0)" ::: "memory");
        } else {
            XB_SPIN(xb_ld(&bar[XB_XGEN(b.x)]) == gen, bar);
            __builtin_amdgcn_fence(__ATOMIC_ACQUIRE, "agent");
            asm volatile("s_waitcnt vmcnt(0)" ::: "memory");
        }
    }
    __syncthreads();
}

typedef unsigned short bf16_t;
typedef short bf16x8 __attribute__((ext_vector_type(8)));
typedef short bf16x4 __attribute__((ext_vector_type(4)));
typedef float f32x4 __attribute__((ext_vector_type(4)));
typedef float f32x2 __attribute__((ext_vector_type(2)));
typedef float f32x16 __attribute__((ext_vector_type(16)));
typedef unsigned u32x4 __attribute__((ext_vector_type(4)));
typedef unsigned u32x2 __attribute__((ext_vector_type(2)));

constexpr int DM = 1024, NB = 16, SEQ = 4096, MT = NB * SEQ, MEML = 256, DEPTH = 4, NEXP = 32;
constexpr int NT_MAX = 1024 + 32;
constexpr int NSLOT = NT_MAX * 256;
constexpr float ALPHA = 1.681792830507429f;
constexpr float LN_EPS = 1e-5f;
constexpr int ROPE_POS = 5120;

constexpr int LDS_STAGE = 131072, MISC_OFF = 135168, ROWIDX_OFF = MISC_OFF + 8192, LDS_BYTES = ROWIDX_OFF + 33 * 512;

constexpr size_t AL(size_t x) { return (x + 255) & ~(size_t)255; }
constexpr size_t WS_CTL = 0;
constexpr size_t CTL_BAR = 0;
constexpr size_t CTL_CNT = 1u << 20;
constexpr size_t CTL_BYTES = (1u << 20) + 4096;
constexpr size_t WS_LB = 2u << 20;
constexpr size_t WS_S5LAM = WS_LB + AL(2 * 1024 * 4);
constexpr size_t WS_S5BB = WS_S5LAM + AL(64 * 64 * 2 * 4);
constexpr size_t WS_S5C = WS_S5BB + AL(64 * 64 * 32 * 4);
constexpr size_t WS_S5BT = WS_S5C + AL(64 * 16 * 128 * 2);
constexpr size_t WS_ROPE = WS_S5BT + AL(64 * 128 * 16 * 2);
constexpr size_t WS_WRHI = WS_ROPE + AL((size_t)ROPE_POS * 32 * 2 * 4);
constexpr size_t WS_WRLO = WS_WRHI + AL(4 * 32 * 1024 * 2);
constexpr size_t WS_B1H = WS_WRLO + AL(4 * 32 * 1024 * 2);
constexpr size_t WS_B2H = WS_B1H + AL(4 * 32 * 2048 * 2);
constexpr size_t WS_TOPI = WS_B2H + AL(4 * 32 * 1024 * 2);
constexpr size_t WS_GATE = WS_TOPI + AL((size_t)MT * 4 * 4);
constexpr size_t WS_TSLOT = WS_GATE + AL((size_t)MT * 4 * 4);
constexpr size_t WS_LIST = WS_TSLOT + AL((size_t)MT * 4 * 4);
constexpr size_t WS_LSE = WS_LIST + AL((size_t)32 * 65536 * 4);
constexpr size_t WS_HGS = WS_LSE + AL((size_t)MT * 48 * 4);
constexpr size_t HGS1 = (size_t)(MT / 16) * 1024 * 4;
constexpr size_t WS_MEMB = WS_HGS + AL(3 * HGS1);
constexpr size_t WS_KMEM = WS_MEMB + AL((size_t)4096 * 1024 * 2);
constexpr size_t WS_VTMEM = WS_KMEM + AL((size_t)4096 * 1024 * 2);
constexpr size_t WS_WAIN = WS_VTMEM + AL((size_t)4096 * 1024 * 2);
constexpr size_t WS_WAOUT = WS_WAIN + AL((size_t)2 * 4096 * 1024 * 2);
constexpr size_t WS_WBIN = WS_WAOUT + AL((size_t)2 * 1024 * 1024 * 2);
constexpr size_t WS_WBOUT = WS_WBIN + AL((size_t)9216 * 1024 * 2);
constexpr size_t WS_WGLU = WS_WBOUT + AL((size_t)1024 * 1024 * 2);
constexpr size_t WS_WKV = WS_WGLU + AL((size_t)2048 * 1024 * 2);
constexpr size_t WS_WQ = WS_WKV + AL((size_t)2048 * 1024 * 2);
constexpr size_t WS_WO = WS_WQ + AL((size_t)4 * 1024 * 1024 * 2);
constexpr size_t WS_W1 = WS_WO + AL((size_t)4 * 1024 * 1024 * 2);
constexpr size_t WS_W2 = WS_W1 + AL((size_t)128 * 2048 * 1024 * 2);
constexpr size_t ACT1 = (size_t)MT * 1024 * 2;
constexpr size_t WS_H = WS_W2 + AL((size_t)128 * 1024 * 1024 * 2);
constexpr size_t WS_MIX = WS_H + ACT1;
constexpr size_t WS_T0 = WS_MIX + ACT1;
constexpr size_t WS_T1 = WS_T0 + ACT1;
constexpr size_t WS_WAIN8 = WS_T1 + ACT1;
constexpr size_t WS_H8 = WS_WAIN8 + AL((size_t)2 * 4096 * 1024);
constexpr size_t WS_BIG = WS_H8 + ACT1 / 2;
constexpr size_t BA_Q = 0, BA_E1 = ACT1, BA_KI = 2 * ACT1, BA_VT = 3 * ACT1, BA_G = 4 * ACT1, BA_KIT = 5 * ACT1;
constexpr size_t BB_PROJ = 0, BB_OG = (size_t)MT * 9216 * 2;
constexpr size_t MOE1 = (size_t)NSLOT * 1024 * 2;
constexpr size_t BM_XS = 0, BM_ACT = MOE1, BM_YS = 2 * MOE1;
constexpr size_t BIG_BYTES = 3 * MOE1 > (BB_OG + 3 * ACT1) ? 3 * MOE1 : (BB_OG + 3 * ACT1);
constexpr size_t WS_END = WS_BIG + BIG_BYTES;

struct Params {
    const float* in[29]; const int* pos; float* out; unsigned char* ws;
    int lo, hi, li, pad;
};

__device__ __forceinline__ float bf2f(bf16_t v) { return __uint_as_float(((unsigned)v) << 16); }
__device__ __forceinline__ bf16_t f2bf(float f) { unsigned u = __float_as_uint(f); u += 0x7FFFu + ((u >> 16) & 1u); return (bf16_t)(u >> 16); }
__device__ __forceinline__ unsigned pk2(float lo, float hi) { return pg8::cvt_pk_bf16(lo, hi); }
__device__ __forceinline__ unsigned pk4_fp8(float a, float b, float c, float d) { int w = 0; w = __builtin_amdgcn_cvt_pk_fp8_f32(a, b, w, false); w = __builtin_amdgcn_cvt_pk_fp8_f32(c, d, w, true); return (unsigned)w; }
__device__ __forceinline__ f32x2 fp8x2_lo(unsigned w) { return __builtin_amdgcn_cvt_pk_f32_fp8((int)w, false); }
__device__ __forceinline__ f32x2 fp8x2_hi(unsigned w) { return __builtin_amdgcn_cvt_pk_f32_fp8((int)w, true); }
__device__ __forceinline__ u32x4 f8x8_to_bf16x8(u32x2 w) {
    const f32x2 a = fp8x2_lo(w.x), b = fp8x2_hi(w.x), c = fp8x2_lo(w.y), d = fp8x2_hi(w.y);
    u32x4 r; r.x = pg8::cvt_pk_bf16(a.x, a.y); r.y = pg8::cvt_pk_bf16(b.x, b.y); r.z = pg8::cvt_pk_bf16(c.x, c.y); r.w = pg8::cvt_pk_bf16(d.x, d.y); return r; }
__device__ __forceinline__ float lo16(unsigned w) { return __uint_as_float(w << 16); }
__device__ __forceinline__ float hi16(unsigned w) { return __uint_as_float(w & 0xffff0000u); }
__device__ __forceinline__ float sigmoidf_(float x) { return __builtin_amdgcn_rcpf(1.0f + __expf(-x)); }
__device__ __forceinline__ float siluf_(float x) { return x * __builtin_amdgcn_rcpf(1.0f + __expf(-x)); }
__device__ __forceinline__ float gelu_tanh(float y) {
    const float a = y * __builtin_fmaf(y * y, -0.10294323f, -2.3022082f); return y * __builtin_amdgcn_rcpf(1.0f + __builtin_amdgcn_exp2f(a)); }
__device__ __forceinline__ f32x4 mfma32(bf16x8 a, bf16x8 b, f32x4 c) { return __builtin_amdgcn_mfma_f32_16x16x32_bf16(a, b, c, 0, 0, 0); }
#ifndef DBG_NO_MFMA16
#define DBG_NO_MFMA16 1
#endif
__device__ __forceinline__ f32x4 mfma16(bf16x4 a, bf16x4 b, f32x4 c) {
#if DBG_NO_MFMA16
    const bf16x8 a8 = {a[0], a[1], a[2], a[3], 0, 0, 0, 0}, b8 = {b[0], b[1], b[2], b[3], 0, 0, 0, 0};
    return __builtin_amdgcn_mfma_f32_16x16x32_bf16(a8, b8, c, 0, 0, 0);
#else
    return __builtin_amdgcn_mfma_f32_16x16x16bf16_1k(a, b, c, 0, 0, 0);
#endif
}
__device__ __forceinline__ bf16x8 mk8(u32x2 a, u32x2 b) { u32x4 w; w.x = a.x; w.y = a.y; w.z = b.x; w.w = b.y; return __builtin_bit_cast(bf16x8, w); }
__device__ __forceinline__ bf16x8 mk8f(f32x4 a, f32x4 b) { u32x4 w; w.x = pk2(a[0], a[1]); w.y = pk2(a[2], a[3]); w.z = pk2(b[0], b[1]); w.w = pk2(b[2], b[3]); return __builtin_bit_cast(bf16x8, w); }
__device__ __forceinline__ bf16x4 mk4f(f32x4 a) { u32x2 w; w.x = pk2(a[0], a[1]); w.y = pk2(a[2], a[3]); return __builtin_bit_cast(bf16x4, w); }

template <bool OUT8 = false> struct EpiPlainT {
    static constexpr bool PERM = true, AFTER_DRAIN = false;
    bf16_t* O; int ldc; int ntn; const float* bias; int bias_stride;
    __device__ __forceinline__ void operator()(const f32x4 (&acc)[2][2][4][2], const pg8::Unit& u, int wr, int wc, int fr, int fq) const {
        const int mat = u.pn / ntn, pnl = u.pn - mat * ntn;
        const int row0 = u.pm * 256 + wr * 64 + fr, col0 = pnl * 256 + wc * 32 + 8 * fq;
        f32x4 bv[2][2];
#pragma unroll
        for (int bj = 0; bj < 2; ++bj)
#pragma unroll
            for (int n = 0; n < 2; ++n) bv[bj][n] = bias ? *(const f32x4*)(bias + (size_t)mat * bias_stride + col0 + bj * 128 + 4 * n) : (f32x4){0.f, 0.f, 0.f, 0.f};
#pragma unroll
        for (int ai = 0; ai < 2; ++ai)
#pragma unroll
            for (int m = 0; m < 4; ++m) { const size_t ro = (size_t)(row0 + ai * 128 + m * 16) * ldc + col0;
#pragma unroll
                for (int bj = 0; bj < 2; ++bj) { const f32x4 v0 = acc[ai][bj][m][0] + bv[bj][0], v1 = acc[ai][bj][m][1] + bv[bj][1];
                    if (OUT8) { u32x2 w8; w8.x = pk4_fp8(v0[0], v0[1], v0[2], v0[3]); w8.y = pk4_fp8(v1[0], v1[1], v1[2], v1[3]); *(u32x2*)((unsigned char*)O + ro + bj * 128) = w8; }
                    else { u32x4 w; w.x = pk2(v0[0], v0[1]); w.y = pk2(v0[2], v0[3]); w.z = pk2(v1[0], v1[1]); w.w = pk2(v1[2], v1[3]);
                        *(u32x4*)(O + ro + bj * 128) = w; } } }
    }
};
typedef EpiPlainT<false> EpiPlain;
struct EpiHgrn {
    static constexpr bool PERM = true, AFTER_DRAIN = false;
    unsigned char* big; const float* lb; float* hgs; int secmap; LAS unsigned char* tl;
    __device__ __forceinline__ void store_t(bf16_t* dstT, size_t step, int col0, const u32x4 (&wt)[2], LAS unsigned char* tb, int fr) const {
        *(LAS u32x4*)(tb + fr * 32) = wt[0]; *(LAS u32x4*)(tb + fr * 32 + 16) = wt[1];
        u32x2 tq[4];
#pragma unroll
        for (int tg = 0; tg < 4; ++tg) tq[tg] = __builtin_bit_cast(u32x2, __builtin_amdgcn_ds_read_tr16_b64_v4i16((LAS bf16x4*)(tb + (4 * tg + (fr >> 2)) * 32 + (fr & 3) * 8)));
        bf16_t* tp = dstT + (step * 1024 + col0 + (fr & 7) + (fr >> 3) * 128) * 16;
        *(u32x4*)tp = (u32x4){tq[0].x, tq[0].y, tq[1].x, tq[1].y}; *(u32x4*)(tp + 8) = (u32x4){tq[2].x, tq[2].y, tq[3].x, tq[3].y};
    }
    __device__ __forceinline__ void operator()(const f32x4 (&acc)[2][2][4][2], const pg8::Unit& u, int wr, int wc, int fr, int fq) const {
        const int sec = (secmap >> (4 * (u.pn >> 2))) & 15, pnl = u.pn & 3;
        LAS unsigned char* tb = tl + (wr * 4 + wc) * 2048 + fq * 512;
        const int row0 = u.pm * 256 + wr * 64 + fr, col0 = pnl * 256 + wc * 32 + 8 * fq;
        f32x4 lbv[2][2];
#pragma unroll
        for (int bj = 0; bj < 2; ++bj)
#pragma unroll
            for (int n = 0; n < 2; ++n) lbv[bj][n] = *(const f32x4*)(lb + col0 + bj * 128 + 4 * n);
#pragma unroll
        for (int ai = 0; ai < 2; ++ai)
#pragma unroll
            for (int m = 0; m < 4; ++m) { const size_t ro = (size_t)(row0 + ai * 128 + m * 16) * 1024 + col0;
#pragma unroll
                for (int bj = 0; bj < 2; ++bj) { f32x4 v0 = acc[ai][bj][m][0], v1 = acc[ai][bj][m][1];
                    if (sec == 1) {
                        f32x4 e1v[2], kiv[2], fgv[2];
#pragma unroll
                        for (int n = 0; n < 2; ++n)
#pragma unroll
                            for (int e = 0; e < 4; ++e) { const float l = lbv[bj][n][e]; const float x = n == 0 ? v0[e] : v1[e];
                                const float fg = fmaxf(l + (1.0f - l) * sigmoidf_(x), 1e-6f); const float kk = 1.0f - fg;
                                float c = fr == 0 ? 1.0f : fg;
                                c *= __int_as_float(__builtin_amdgcn_update_dpp(0x3f800000, __float_as_int(c), 0x111, 0xf, 0xf, false));
                                c *= __int_as_float(__builtin_amdgcn_update_dpp(0x3f800000, __float_as_int(c), 0x112, 0xf, 0xf, false));
                                c *= __int_as_float(__builtin_amdgcn_update_dpp(0x3f800000, __float_as_int(c), 0x114, 0xf, 0xf, false));
                                c *= __int_as_float(__builtin_amdgcn_update_dpp(0x3f800000, __float_as_int(c), 0x118, 0xf, 0xf, false));
                                e1v[n][e] = c; kiv[n][e] = kk * fminf(__builtin_amdgcn_rcpf(c), 5.5406224e34f); fgv[n][e] = fg; }
                        u32x4 w; w.x = pk2(e1v[0][0], e1v[0][1]); w.y = pk2(e1v[0][2], e1v[0][3]); w.z = pk2(e1v[1][0], e1v[1][1]); w.w = pk2(e1v[1][2], e1v[1][3]);
                        *(u32x4*)((bf16_t*)(big + BA_E1) + ro + bj * 128) = w;
                        w.x = pk2(kiv[0][0], kiv[0][1]); w.y = pk2(kiv[0][2], kiv[0][3]); w.z = pk2(kiv[1][0], kiv[1][1]); w.w = pk2(kiv[1][2], kiv[1][3]);
                        *(u32x4*)((bf16_t*)(big + BA_KI) + ro + bj * 128) = w;
                        if (fr == 0 || fr == 15) { float* sp = hgs + (fr == 0 ? HGS1 / 4 : 2 * (HGS1 / 4)) + (size_t)((row0 - fr + ai * 128 + m * 16) >> 4) * 1024 + col0 + bj * 128;
                            *(f32x4*)sp = fr == 0 ? fgv[0] : e1v[0]; *(f32x4*)(sp + 4) = fr == 0 ? fgv[1] : e1v[1]; }
                    } else {
                        if (sec != 2) {
#pragma unroll
                            for (int e = 0; e < 4; ++e) { v0[e] = siluf_(v0[e]); v1[e] = siluf_(v1[e]); } }
                        u32x4 w; w.x = pk2(v0[0], v0[1]); w.y = pk2(v0[2], v0[3]); w.z = pk2(v1[0], v1[1]); w.w = pk2(v1[2], v1[3]);
                        { bf16_t* dst = (bf16_t*)(big + (sec == 0 ? BA_Q : (sec == 2 ? BA_VT : BA_G))); *(u32x4*)(dst + ro + bj * 128) = w; } } }
                }
    }
};
struct EpiRope {
    static constexpr bool PERM = true, AFTER_DRAIN = false;
    bf16_t* O; const int* pos; const float* tab;
    __device__ __forceinline__ void operator()(const f32x4 (&acc)[2][2][4][2], const pg8::Unit& u, int wr, int wc, int fr, int fq) const {
        const int sec = u.pn >> 2, type = sec % 3;
        const int row0 = u.pm * 256 + wr * 64 + fr, col0 = u.pn * 256 + wc * 32 + 8 * fq;
        const int i0 = (wc & 1) * 16 + 4 * fq;
#pragma unroll
        for (int ai = 0; ai < 2; ++ai)
#pragma unroll
            for (int m = 0; m < 4; ++m) { const int row = row0 + ai * 128 + m * 16; bf16_t* rowp = O + (size_t)row * 9216 + col0;
                f32x4 cs0 = {1.f, 0.f, 1.f, 0.f}, cs1 = {1.f, 0.f, 1.f, 0.f};
                if (type < 2) { int pp = pos[row]; pp = pp < 0 ? 0 : (pp >= ROPE_POS ? ROPE_POS - 1 : pp); const float* tp = tab + ((size_t)pp * 32 + i0) * 2; cs0 = *(const f32x4*)tp; cs1 = *(const f32x4*)(tp + 4); }
#pragma unroll
                for (int bj = 0; bj < 2; ++bj) { const f32x4 v0 = acc[ai][bj][m][0], v1 = acc[ai][bj][m][1];
                    u32x4 w;
                    w.x = pk2(v0[0] * cs0[0] - v0[1] * cs0[1], v0[0] * cs0[1] + v0[1] * cs0[0]);
                    w.y = pk2(v0[2] * cs0[2] - v0[3] * cs0[3], v0[2] * cs0[3] + v0[3] * cs0[2]);
                    w.z = pk2(v1[0] * cs1[0] - v1[1] * cs1[1], v1[0] * cs1[1] + v1[1] * cs1[0]);
                    w.w = pk2(v1[2] * cs1[2] - v1[3] * cs1[3], v1[2] * cs1[3] + v1[3] * cs1[2]);
                    u32x2 w8; w8.x = pk4_fp8(lo16(w.x), hi16(w.x), lo16(w.y), hi16(w.y)); w8.y = pk4_fp8(lo16(w.z), hi16(w.z), lo16(w.w), hi16(w.w));
                    *(u32x2*)((unsigned char*)O + (size_t)row * 9216 + col0 + bj * 128) = w8; } }
    }
};
template <int MODE, bool OUT8 = false> struct EpiGlu {
    static constexpr bool PERM = true, AFTER_DRAIN = false;
    struct State { u32x4 ba, bb; };
    bf16_t* O; const bf16_t* bias;
    __device__ __forceinline__ void pre(const pg8::Unit& u, int wc, int fq, State& s) const {
        const int mat = u.pn >> 3, pnl = u.pn & 7, col0 = pnl * 128 + wc * 32 + 8 * fq;
        s.ba = *(const u32x4*)(bias + (size_t)mat * 2048 + col0); s.bb = *(const u32x4*)(bias + (size_t)mat * 2048 + 1024 + col0); }
    __device__ __forceinline__ void operator()(const f32x4 (&acc)[2][2][4][2], const pg8::Unit& u, int wr, int wc, int fr, int fq) const { State s; s.ba = (u32x4){0u, 0u, 0u, 0u}; s.bb = s.ba; (*this)(acc, u, wr, wc, fr, fq, s); }
    __device__ __forceinline__ void operator()(const f32x4 (&acc)[2][2][4][2], const pg8::Unit& u, int wr, int wc, int fr, int fq, const State& s) const {
        const int pnl = u.pn & 7;
        const int row0 = u.pm * 256 + wr * 64 + fr, col0 = pnl * 128 + wc * 32 + 8 * fq;
        f32x4 ba[2], bb[2];
        ba[0] = (f32x4){lo16(s.ba.x), hi16(s.ba.x), lo16(s.ba.y), hi16(s.ba.y)}; ba[1] = (f32x4){lo16(s.ba.z), hi16(s.ba.z), lo16(s.ba.w), hi16(s.ba.w)};
        bb[0] = (f32x4){lo16(s.bb.x), hi16(s.bb.x), lo16(s.bb.y), hi16(s.bb.y)}; bb[1] = (f32x4){lo16(s.bb.z), hi16(s.bb.z), lo16(s.bb.w), hi16(s.bb.w)};
#pragma unroll
        for (int ai = 0; ai < 2; ++ai)
#pragma unroll
            for (int m = 0; m < 4; ++m) { bf16_t* rowp = O + (size_t)(row0 + ai * 128 + m * 16) * 1024 + col0;
                f32x4 r[2];
#pragma unroll
                for (int n = 0; n < 2; ++n) { const f32x4 a = acc[ai][0][m][n] + ba[n], g = acc[ai][1][m][n] + bb[n];
                    if (MODE == 0) {
#pragma unroll
                        for (int e = 0; e < 4; ++e) r[n][e] = a[e] * sigmoidf_(g[e]);
                    } else {
#pragma unroll
                        for (int e = 0; e < 4; e += 2) {
                            const f32x2 hg = {fminf(a[e], 7.0f), fminf(a[e + 1], 7.0f)}, hl = {__builtin_amdgcn_fmed3f(g[e], -7.0f, 7.0f), __builtin_amdgcn_fmed3f(g[e + 1], -7.0f, 7.0f)};
                            const f32x2 t = hg * (-1.702f * 1.4426950408889634f);
                            f32x2 ex; ex.x = __builtin_amdgcn_exp2f(t.x); ex.y = __builtin_amdgcn_exp2f(t.y);
                            const f32x2 den = ex + 1.0f; f32x2 sg; sg.x = __builtin_amdgcn_rcpf(den.x); sg.y = __builtin_amdgcn_rcpf(den.y);
                            const f32x2 o2 = (hg * sg) * (hl + 1.0f); r[n][e] = o2.x; r[n][e + 1] = o2.y; } } }
                if (OUT8) { u32x2 w8; w8.x = pk4_fp8(r[0][0], r[0][1], r[0][2], r[0][3]); w8.y = pk4_fp8(r[1][0], r[1][1], r[1][2], r[1][3]);
                    *(u32x2*)((unsigned char*)O + (size_t)(row0 + ai * 128 + m * 16) * 1024 + col0) = w8; }
                else { u32x4 w; w.x = pk2(r[0][0], r[0][1]); w.y = pk2(r[0][2], r[0][3]); w.z = pk2(r[1][0], r[1][1]); w.w = pk2(r[1][2], r[1][3]);
                    *(u32x4*)rowp = w; } }
    }
};
struct MoeOrder {
    int G, c, ntn, NT; const LAS unsigned char* tile_e; const LAS int* mi; const int* list; unsigned rowpitch; const LAS unsigned short* rowidx;
    __device__ __forceinline__ void unit_rows(const pg8::Unit& u, int& e, int& i0, int& cn) const { e = (int)tile_e[u.pm]; i0 = (u.pm - mi[1 + e]) * 256; cn = mi[40 + e]; }
    __device__ __forceinline__ int row_tok(int e, int idx, int cn) const { const int ic = idx < cn ? idx : cn - 1; return list[(size_t)e * 65536 + ic]; }
    __device__ __forceinline__ unsigned row_bytes(int e, int idx, int cn) const { return (unsigned)row_tok(e, idx, cn) * rowpitch; }
    __device__ __forceinline__ bool next(int i, pg8::Unit& u) const {
        int rt, pn;
        if (G == 256) { const int x = c & 7, s = c >> 3, rpx = 32 / ntn; rt = i * (256 / ntn) + x * rpx + s / ntn; pn = s % ntn; }
        else { const long L = (long)i * G + c; rt = (int)(L / ntn); pn = (int)(L % ntn); }
        if (rt >= NT) return false;
        u.pm = rt; u.pn = (int)tile_e[rt] * ntn + pn; return true;
    }
    __device__ __forceinline__ void a_ready(const pg8::Unit&) const {}
    __device__ __forceinline__ void done(const pg8::Unit&) const {}
};

#ifndef FP8_DIL
#define FP8_DIL 1
#endif
#ifndef FP8_HGRN
#define FP8_HGRN 0
#endif
#ifndef FP8_MIX
#define FP8_MIX 1
#endif
#ifndef FP8_DILOUT
#define FP8_DILOUT 1
#endif
#ifndef FP8_HGRN_QI
#define FP8_HGRN_QI 1
#endif
#ifndef FP8_HGRN_G
#define FP8_HGRN_G 0
#endif
#ifndef FP8_GLU
#define FP8_GLU 1
#endif
#ifndef FP8_Q
#define FP8_Q 1
#endif
#ifndef FP8_O
#define FP8_O 1
#endif
#ifndef FP8_MIXOUT
#define FP8_MIXOUT 0
#endif
#ifndef DBG_MASK
#define DBG_MASK 31
#endif
#define DBG_NO_MOE (!(DBG_MASK & 16))
#define DBG_SKIP_CROSS 0
#define DBG_TRIVIAL_SCAN 0
#define DBG_HGRN_SAFE 0
#define DBG_TRIVIAL_IN 0
__device__ __forceinline__ int l_tid() { int t = threadIdx.x; asm volatile("" : "+v"(t)); return t; }
__device__ __forceinline__ int l_bid() { int b = blockIdx.x; asm volatile("" : "+s"(b)); return b; }
__device__ __forceinline__ int l_gdim() { int g = gridDim.x; asm volatile("" : "+s"(g)); return g; }
#define LAUNDER_IDS() const int TIDX = l_tid(), BIDX = l_bid(), GDIMX = l_gdim(); (void)TIDX; (void)BIDX; (void)GDIMX

__device__ __forceinline__ int map_row(int mode, int n) {
    if (mode == 1) { const int sec = n >> 10; if ((sec % 3) == 2) return n; const int j = n & 63; const int jj = (j < 32) ? 2 * j : 2 * (j - 32) + 1; return (n & ~63) | jj; }
    if (mode == 2) { const int half = n >> 10, j = n & 1023; return ((j >> 7) << 8) | (half << 7) | (j & 127); }
    if (mode == 3) { const int s = n >> 10; const int d = s == 0 ? 0 : (s == 1 ? 3 : s - 1); return (d << 10) | (n & 1023); }
    if (mode == 4) { if (n < 1024) return n; const int d = n & 255; return (n & ~255) | (((d >> 2) & 15) << 4) | ((d >> 6) << 2) | (d & 3); }
    return n;
}
__device__ __forceinline__ void conv_group(LAS unsigned char* lds, const float* src, bf16_t* dst, int njobs, int N, int mode) {
    LAUNDER_IDS();
    LAS bf16_t* T = (LAS bf16_t*)lds;
    const int tid = TIDX; const int tn = N / 64, tpj = 16 * tn; const long total = (long)njobs * tpj;
    const int lk = tid >> 4, ln4 = (tid & 15) * 4;
    f32x4 na0 = {0.f, 0.f, 0.f, 0.f}, na1 = na0, nb0 = na0, nb1 = na0;
#define CG_FETCH(n0_, n1_, t_) do { const long tt_ = (t_) < total ? (t_) : (long)BIDX % total; const int job_ = (int)(tt_ / tpj), r_ = (int)(tt_ % tpj), kt_ = r_ / tn, nt_ = r_ % tn; \
        const float* s_ = src + (size_t)job_ * 1024 * N + (size_t)(kt_ * 64) * N + nt_ * 64; n0_ = *(const f32x4*)(s_ + (size_t)lk * N + ln4); n1_ = *(const f32x4*)(s_ + (size_t)(lk + 32) * N + ln4); } while (0)
#define CG_PROC(n0_, n1_, t_, tnext_) do { const long tc_ = (t_); const int job = (int)(tc_ / tpj), r = (int)(tc_ % tpj), kt = r / tn, nt = r % tn; \
        const f32x4 v0 = n0_, v1 = n1_; \
        CG_FETCH(n0_, n1_, tnext_); \
        T[(ln4 + 0) * 72 + lk] = f2bf(v0[0]); T[(ln4 + 1) * 72 + lk] = f2bf(v0[1]); T[(ln4 + 2) * 72 + lk] = f2bf(v0[2]); T[(ln4 + 3) * 72 + lk] = f2bf(v0[3]); \
        T[(ln4 + 0) * 72 + lk + 32] = f2bf(v1[0]); T[(ln4 + 1) * 72 + lk + 32] = f2bf(v1[1]); T[(ln4 + 2) * 72 + lk + 32] = f2bf(v1[2]); T[(ln4 + 3) * 72 + lk + 32] = f2bf(v1[3]); \
        __syncthreads(); \
        { const int n = tid >> 3, kc = (tid & 7) * 8; const u32x4 w = *(const LAS u32x4*)(T + n * 72 + kc); \
          const int nn = map_row(mode, nt * 64 + n); \
          *(u32x4*)(dst + (size_t)job * N * 1024 + (size_t)nn * 1024 + kt * 64 + kc) = w; } \
        __syncthreads(); } while (0)
    if ((long)BIDX < total) { CG_FETCH(na0, na1, (long)BIDX); CG_FETCH(nb0, nb1, (long)BIDX + GDIMX); }
    for (long t = BIDX; t < total; t += 2 * (long)GDIMX) {
        CG_PROC(na0, na1, t, t + 2 * (long)GDIMX);
        if (t + GDIMX < total) CG_PROC(nb0, nb1, t + GDIMX, t + 3 * (long)GDIMX);
    }
#undef CG_FETCH
#undef CG_PROC
}
__device__ __forceinline__ void conv_group8(LAS unsigned char* lds, const float* src, unsigned char* dst, int njobs, int N, int mode, float scale, int vbid = -1, int vgrid = 0) {
    const int TIDX = l_tid(), BIDX = vbid >= 0 ? vbid : l_bid(), GDIMX = vbid >= 0 ? vgrid : l_gdim();
    LAS unsigned char* T = lds;
    const int tid = TIDX; const int tn = N / 128, tpj = 16 * tn; const long total = (long)njobs * tpj;
    const int kb = tid & 15, nb = tid >> 4;
    f32x4 nva[4], nvb[4];
#define CG_FETCH(nv_, t_) do { const long tt_ = (t_) < total ? (t_) : (long)BIDX % total; const int job_ = (int)(tt_ / tpj), r_ = (int)(tt_ % tpj), kt_ = r_ / tn, nt_ = r_ % tn; \
        const float* s_ = src + (size_t)job_ * 1024 * N + (size_t)(kt_ * 64 + 4 * kb) * N + nt_ * 128 + 4 * nb; \
        _Pragma("unroll") for (int i = 0; i < 4; ++i) nv_[i] = *(const f32x4*)(s_ + (size_t)i * N); } while (0)
#define CG_PROC(nv_, t_, tnext_) do { const long tc_ = (t_); const int job = (int)(tc_ / tpj), r = (int)(tc_ % tpj), kt = r / tn, nt = r % tn; \
        f32x4 v[4]; _Pragma("unroll") for (int i = 0; i < 4; ++i) v[i] = nv_[i] * scale; \
        CG_FETCH(nv_, tnext_); \
        _Pragma("unroll") for (int e = 0; e < 4; ++e) *(LAS unsigned*)(T + (4 * nb + e) * 80 + 4 * kb) = pk4_fp8(v[0][e], v[1][e], v[2][e], v[3][e]);     \
        __syncthreads(); \
        { const int n = tid >> 2, kc = (tid & 3) * 16; const u32x4 w = *(const LAS u32x4*)(T + n * 80 + kc); \
          const int nn = map_row(mode, nt * 128 + n); \
          *(u32x4*)(dst + (size_t)job * N * 1024 + (size_t)nn * 1024 + kt * 64 + kc) = w; } \
        __syncthreads(); } while (0)
    if ((long)BIDX < total) { CG_FETCH(nva, (long)BIDX); CG_FETCH(nvb, (long)BIDX + GDIMX); }
    for (long t = BIDX; t < total; t += 2 * (long)GDIMX) {
        CG_PROC(nva, t, t + 2 * (long)GDIMX);
        if (t + GDIMX < total) CG_PROC(nvb, t + GDIMX, t + 3 * (long)GDIMX);
    }
#undef CG_FETCH
#undef CG_PROC
}
__device__ __forceinline__ void cvt_rows(const float* src, bf16_t* dst, size_t n8) {
    LAUNDER_IDS();
    for (size_t i = (size_t)BIDX * 512 + TIDX; i < n8; i += (size_t)GDIMX * 512) {
        const f32x4 a = *(const f32x4*)(src + i * 8), b = *(const f32x4*)(src + i * 8 + 4);
        u32x4 w; w.x = pk2(a[0], a[1]); w.y = pk2(a[2], a[3]); w.z = pk2(b[0], b[1]); w.w = pk2(b[2], b[3]);
        *(u32x4*)(dst + i * 8) = w; }
}
__device__ __forceinline__ void prologue_phase(const Params& p, LAS unsigned char* lds) {
    LAUNDER_IDS();
    unsigned char* ws = p.ws;
    conv_group8(lds, p.in[25], ws + WS_W1, 96, 2048, 2, 64.0f);
    conv_group8(lds, p.in[27], ws + WS_W2, 96, 1024, 0, 64.0f);
    conv_group(lds, p.in[5], (bf16_t*)(ws + WS_WAIN), 2, 4096, 0);
#if FP8_HGRN || FP8_HGRN_G || FP8_HGRN_QI
    conv_group8(lds, p.in[5], ws + WS_WAIN8, 2, 4096, 3, 64.0f);
#endif
#if FP8_MIXOUT
    conv_group8(lds, p.in[8], ws + WS_WAOUT, 2, 1024, 0, 64.0f);
#else
    conv_group(lds, p.in[8], (bf16_t*)(ws + WS_WAOUT), 2, 1024, 0);
#endif
#if FP8_DIL
    conv_group8(lds, p.in[9], ws + WS_WBIN, 1, 9216, 1, 64.0f);
#else
    conv_group(lds, p.in[9], (bf16_t*)(ws + WS_WBIN), 1, 9216, 1);
#endif
#if FP8_MIXOUT || FP8_DILOUT
    conv_group8(lds, p.in[10], ws + WS_WBOUT, 1, 1024, 0, 64.0f);
#else
    conv_group(lds, p.in[10], (bf16_t*)(ws + WS_WBOUT), 1, 1024, 0);
#endif
#if FP8_GLU
    conv_group8(lds, p.in[19], ws + WS_WGLU, 1, 2048, 2, 64.0f);
#else
    conv_group(lds, p.in[19], (bf16_t*)(ws + WS_WGLU), 1, 2048, 2);
#endif
    conv_group(lds, p.in[20], (bf16_t*)(ws + WS_WKV), 1, 2048, 4);
#if FP8_Q
    conv_group8(lds, p.in[21], ws + WS_WQ, 4, 1024, 0, 64.0f);
#else
    conv_group(lds, p.in[21], (bf16_t*)(ws + WS_WQ), 4, 1024, 0);
#endif
#if FP8_O
    conv_group8(lds, p.in[22], ws + WS_WO, 4, 1024, 0, 64.0f);
#else
    conv_group(lds, p.in[22], (bf16_t*)(ws + WS_WO), 4, 1024, 0);
#endif
    { const size_t n8 = (size_t)MT * 1024 / 8, gs = (size_t)GDIMX * 512;
      for (size_t i0 = (size_t)BIDX * 512 + TIDX; i0 < n8; i0 += 4 * gs) {
        f32x4 a[4], b2[4];
#pragma unroll
        for (int u = 0; u < 4; ++u) { const size_t i = i0 + u * gs < n8 ? i0 + u * gs : i0; a[u] = *(const f32x4*)(p.in[0] + i * 8); b2[u] = *(const f32x4*)(p.in[0] + i * 8 + 4); }
#pragma unroll
        for (int u = 0; u < 4; ++u) { const size_t i = i0 + u * gs; if (i < n8) {
            u32x4 wh; wh.x = pk2(a[u][0], a[u][1]); wh.y = pk2(a[u][2], a[u][3]); wh.z = pk2(b2[u][0], b2[u][1]); wh.w = pk2(b2[u][2], b2[u][3]); *(u32x4*)(ws + WS_H + i * 16) = wh;
            u32x2 w; w.x = pk4_fp8(a[u][0], a[u][1], a[u][2], a[u][3]); w.y = pk4_fp8(b2[u][0], b2[u][1], b2[u][2], b2[u][3]); *(u32x2*)(ws + WS_H8 + i * 8) = w; } } } }
    cvt_rows(p.in[1], (bf16_t*)(ws + WS_MEMB), (size_t)4096 * 1024 / 8);
    const size_t gtid = (size_t)BIDX * 512 + TIDX, gsz = (size_t)GDIMX * 512;
    for (size_t i = gtid; i < (size_t)4 * 32 * 2048; i += gsz) ((bf16_t*)(ws + WS_B1H))[i] = f2bf(p.in[26][i]);
    for (size_t i = gtid; i < (size_t)4 * 32 * 1024; i += gsz) ((bf16_t*)(ws + WS_B2H))[i] = f2bf(p.in[28][i]);
    for (size_t i = gtid; i < 1024; i += gsz) { const float* a = p.in[6]; const float v0 = a[i], v1 = a[1024 + i], v2 = a[2048 + i], v3 = a[3072 + i];
        const float mx = fmaxf(fmaxf(v0, v1), fmaxf(v2, v3)); const float e0 = expf(v0 - mx), e1 = expf(v1 - mx), e2 = expf(v2 - mx), e3 = expf(v3 - mx); const float s = e0 + e1 + e2 + e3;
        float* lb = (float*)(ws + WS_LB); lb[i] = 0.0f; lb[1024 + i] = (e1 + e2 + e3) / s; }
    for (size_t i = gtid; i < (size_t)4 * 32 * 1024; i += gsz) { const int l = (int)(i >> 15), e = (int)((i >> 10) & 31), k = (int)(i & 1023);
        const float w = p.in[23][((size_t)l * 1024 + k) * 32 + e]; const bf16_t hi = f2bf(w); ((bf16_t*)(ws + WS_WRHI))[i] = hi; ((bf16_t*)(ws + WS_WRLO))[i] = f2bf(w - bf2f(hi)); }
    for (size_t i = gtid; i < (size_t)ROPE_POS * 32; i += gsz) { const int pp = (int)(i >> 5), f = (int)(i & 31);
        const float invf = (float)pow(10000.0, -(double)f / 32.0); const float ang = (float)pp * invf; const double a = (double)ang;
        float* t = (float*)(ws + WS_ROPE); t[i * 2] = (float)cos(a); t[i * 2 + 1] = (float)sin(a); }
    for (size_t i = gtid; i < 64 * 64; i += gsz) { const int g = (int)(i >> 6);
        const double ar = p.in[11][i], ai = p.in[12][i], dt = exp((double)p.in[13][g]);
        const double mag = exp(ar * dt), lr = mag * cos(ai * dt), li = mag * sin(ai * dt), den = ar * ar + ai * ai;
        const double fr = ((lr - 1.0) * ar + li * ai) / den, fi = (li * ar - (lr - 1.0) * ai) / den;
        float* lam = (float*)(ws + WS_S5LAM); lam[i * 2] = (float)lr; lam[i * 2 + 1] = (float)li;
        float* bbp = (float*)(ws + WS_S5BB) + i * 32;
        bf16_t* btp = (bf16_t*)(ws + WS_S5BT) + (size_t)g * 128 * 16; const int n = (int)(i & 63);
        for (int c = 0; c < 16; ++c) { const double br = p.in[14][i * 16 + c], bi = p.in[15][i * 16 + c]; const float vr = (float)(fr * br - fi * bi), vi = (float)(fr * bi + fi * br);
            bbp[c] = vr; bbp[16 + c] = vi; btp[n * 16 + c] = f2bf(vr); btp[(64 + n) * 16 + c] = f2bf(vi); } }
    for (size_t i = gtid; i < (size_t)64 * 16 * 128; i += gsz) { const int k = (int)(i & 127), gc = (int)(i >> 7);
        const float v = (k < 64) ? p.in[16][(size_t)gc * 64 + k] : -p.in[17][(size_t)gc * 64 + (k - 64)]; ((bf16_t*)(ws + WS_S5C))[i] = f2bf(v); }
}


__device__ __forceinline__ void dbg_scan_phase(const Params& p) {
    LAUNDER_IDS();
    unsigned char* ws = p.ws; unsigned* flag = (unsigned*)(ws + CTL_CNT) + 512;
    const size_t gtid = (size_t)BIDX * 512 + TIDX, gsz = (size_t)GDIMX * 512; unsigned f = 0;
    const bf16_t* K = (const bf16_t*)(ws + WS_KMEM); const bf16_t* VT = (const bf16_t*)(ws + WS_VTMEM); const bf16_t* Q = (const bf16_t*)(ws + WS_T0); const bf16_t* O = (const bf16_t*)(ws + WS_T1);
    for (size_t i = gtid; i < (size_t)4096 * 1024; i += gsz) { if ((K[i] & 0x7F80) == 0x7F80) f |= 1u; if ((VT[i] & 0x7F80) == 0x7F80) f |= 2u; }
    for (size_t i = gtid; i < (size_t)MT * 1024; i += gsz) { if ((Q[i] & 0x7F80) == 0x7F80) f |= 4u; if ((O[i] & 0x7F80) == 0x7F80) f |= 8u; }
    if (f) atomicOr(flag, f);
}
template <int MODE>
__device__ __forceinline__ void ln_phase(const Params& p, LAS unsigned char* lds, int layer, int which, const bf16_t* mix, bool final, bool use_mix = true, unsigned char* h8 = nullptr, bool dry = false, bool mix8 = false, bool wgrows = false) {
    LAUNDER_IDS();
    unsigned char* ws = p.ws; bf16_t* h = (bf16_t*)(ws + WS_H); bf16_t* hout = dry ? (bf16_t*)(ws + WS_BIG + 5 * ACT1 + ACT1) : h;
    const int lane = TIDX & 63, wave = TIDX >> 6;
    const float* gp = p.in[3] + (size_t)(layer * 3 + which) * 1024; const float* bp = p.in[4] + (size_t)(layer * 3 + which) * 1024;
    const int c0 = lane * 8, c1 = 512 + lane * 8;
    f32x4 gv[4], bv[4];
    gv[0] = *(const f32x4*)(gp + c0); gv[1] = *(const f32x4*)(gp + c0 + 4); gv[2] = *(const f32x4*)(gp + c1); gv[3] = *(const f32x4*)(gp + c1 + 4);
    bv[0] = *(const f32x4*)(bp + c0); bv[1] = *(const f32x4*)(bp + c0 + 4); bv[2] = *(const f32x4*)(bp + c1); bv[3] = *(const f32x4*)(bp + c1 + 4);
    const int* tslot = (const int*)(ws + WS_TSLOT); const float* gates = (const float*)(ws + WS_GATE); const LAS int* mi_ = (const LAS int*)(lds + MISC_OFF + 64);
    const int stride = wgrows ? 8 : GDIMX * 8, row0 = wgrows ? BIDX * 256 + wave : BIDX * 8 + wave, rend = wgrows ? BIDX * 256 + 256 : MT;
    constexpr int NM = MODE == 0 ? 1 : 4;
    u32x4 nh0, nh1, nm0[NM], nm1[NM], nb0[NM], nb1[NM]; const bf16_t* b2h = (const bf16_t*)(ws + WS_B2H) + (size_t)layer * 32 * 1024; int4 ncode = make_int4(0, 0, 0, 0); f32x4 ngate = {0.f, 0.f, 0.f, 0.f}, cgate = {0.f, 0.f, 0.f, 0.f};
#define LN_SLOTS(code_, out_) do { out_[0] = mi_[1 + ((unsigned)code_.x >> 24)] * 256 + (code_.x & 0xffffff); out_[1] = mi_[1 + ((unsigned)code_.y >> 24)] * 256 + (code_.y & 0xffffff); \
        out_[2] = mi_[1 + ((unsigned)code_.z >> 24)] * 256 + (code_.z & 0xffffff); out_[3] = mi_[1 + ((unsigned)code_.w >> 24)] * 256 + (code_.w & 0xffffff); } while (0)
#define LN_FETCH(r_, code_) do { const int rr_ = (r_) < rend ? (r_) : row0; nh0 = *(const u32x4*)(h + (size_t)rr_ * 1024 + c0); nh1 = *(const u32x4*)(h + (size_t)rr_ * 1024 + c1); \
        if (MODE == 0) { if (mix8) { const u32x2 y0_ = *(const u32x2*)((const unsigned char*)mix + (size_t)rr_ * 1024 + c0), y1_ = *(const u32x2*)((const unsigned char*)mix + (size_t)rr_ * 1024 + c1); \
                nm0[0] = (u32x4){y0_.x, y0_.y, 0u, 0u}; nm1[0] = (u32x4){y1_.x, y1_.y, 0u, 0u}; } \
            else { nm0[0] = *(const u32x4*)(mix + (size_t)rr_ * 1024 + c0); nm1[0] = *(const u32x4*)(mix + (size_t)rr_ * 1024 + c1); } } \
        else { int sl_[4]; LN_SLOTS(code_, sl_); const int ex_[4] = {(int)((unsigned)code_.x >> 24), (int)((unsigned)code_.y >> 24), (int)((unsigned)code_.z >> 24), (int)((unsigned)code_.w >> 24)}; \
            _Pragma("unroll") for (int k = 0; k < NM; ++k) { const u32x2 y0_ = *(const u32x2*)((const unsigned char*)mix + (size_t)sl_[k] * 1024 + c0), y1_ = *(const u32x2*)((const unsigned char*)mix + (size_t)sl_[k] * 1024 + c1); \
                nm0[k] = (u32x4){y0_.x, y0_.y, 0u, 0u}; nm1[k] = (u32x4){y1_.x, y1_.y, 0u, 0u};     \
                nb0[k] = *(const u32x4*)(b2h + (size_t)ex_[k] * 1024 + c0); nb1[k] = *(const u32x4*)(b2h + (size_t)ex_[k] * 1024 + c1); } } } while (0)
    if (MODE == 1) { ncode = *(const int4*)(tslot + (size_t)row0 * 4); ngate = *(const f32x4*)(gates + (size_t)row0 * 4); }
    LN_FETCH(row0, ncode);
    if (MODE == 1) { cgate = ngate; const int r2 = row0 + stride < rend ? row0 + stride : row0; ncode = *(const int4*)(tslot + (size_t)r2 * 4); ngate = *(const f32x4*)(gates + (size_t)r2 * 4); }
    const unsigned dmy0 = ((const unsigned short*)gp)[lane], dmy1 = ((const unsigned short*)bp)[lane];
    for (int row = row0; row < rend; row += stride) {
        const u32x4 h0 = nh0, h1 = nh1; u32x4 m0[NM], m1[NM], q0[NM], q1[NM];
#pragma unroll
        for (int k = 0; k < NM; ++k) { m0[k] = nm0[k]; m1[k] = nm1[k]; if (MODE == 1) { q0[k] = nb0[k]; q1[k] = nb1[k]; } }
        const f32x4 gt = cgate;
        LN_FETCH(row + stride, ncode);
        if (MODE == 1) { cgate = ngate; const int r2 = row + 2 * stride < rend ? row + 2 * stride : row0; ncode = *(const int4*)(tslot + (size_t)r2 * 4); ngate = *(const f32x4*)(gates + (size_t)r2 * 4); }
        float v[16];
#pragma unroll
        for (int i = 0; i < 4; ++i) { v[2 * i] = ALPHA * lo16(h0[i]); v[2 * i + 1] = ALPHA * hi16(h0[i]); v[8 + 2 * i] = ALPHA * lo16(h1[i]); v[8 + 2 * i + 1] = ALPHA * hi16(h1[i]); }
        if (MODE == 0) { if (use_mix) {
#pragma unroll
            for (int i = 0; i < 4; ++i) {
                if (mix8) { const f32x2 ya = (i & 1) ? fp8x2_hi(m0[0][i >> 1]) : fp8x2_lo(m0[0][i >> 1]), yb = (i & 1) ? fp8x2_hi(m1[0][i >> 1]) : fp8x2_lo(m1[0][i >> 1]);
                    v[2 * i] += ya.x; v[2 * i + 1] += ya.y; v[8 + 2 * i] += yb.x; v[8 + 2 * i + 1] += yb.y; }
                else { v[2 * i] += lo16(m0[0][i]); v[2 * i + 1] += hi16(m0[0][i]); v[8 + 2 * i] += lo16(m1[0][i]); v[8 + 2 * i + 1] += hi16(m1[0][i]); } } }
        } else if (!DBG_NO_MOE) {
#pragma unroll
            for (int k = 0; k < NM; ++k) { const float gk = gt[k];
#pragma unroll
                for (int i = 0; i < 4; ++i) { const f32x2 ya = (i & 1) ? fp8x2_hi(m0[k][i >> 1]) : fp8x2_lo(m0[k][i >> 1]), yb = (i & 1) ? fp8x2_hi(m1[k][i >> 1]) : fp8x2_lo(m1[k][i >> 1]);
                    v[2 * i] += gk * (ya.x + lo16(q0[k][i])); v[2 * i + 1] += gk * (ya.y + hi16(q0[k][i]));
                    v[8 + 2 * i] += gk * (yb.x + lo16(q1[k][i])); v[8 + 2 * i + 1] += gk * (yb.y + hi16(q1[k][i])); } }
        }
        float s = 0.f;
#pragma unroll
        for (int i = 0; i < 16; ++i) s += v[i];
#pragma unroll
        for (int o = 32; o >= 1; o >>= 1) s += __shfl_xor(s, o);
        const float mean = s * (1.0f / 1024.0f); float q = 0.f;
#pragma unroll
        for (int i = 0; i < 16; ++i) { v[i] -= mean; q += v[i] * v[i]; }
#pragma unroll
        for (int o = 32; o >= 1; o >>= 1) q += __shfl_xor(q, o);
        const float rstd = rsqrtf(q * (1.0f / 1024.0f) + LN_EPS);
#pragma unroll
        for (int i = 0; i < 4; ++i)
#pragma unroll
            for (int e = 0; e < 4; ++e) v[4 * i + e] = v[4 * i + e] * rstd * gv[i][e] + bv[i][e];
        u32x4 w0, w1; w0.x = pk2(v[0], v[1]); w0.y = pk2(v[2], v[3]); w0.z = pk2(v[4], v[5]); w0.w = pk2(v[6], v[7]);
        w1.x = pk2(v[8], v[9]); w1.y = pk2(v[10], v[11]); w1.z = pk2(v[12], v[13]); w1.w = pk2(v[14], v[15]);
        *(u32x4*)(hout + (size_t)row * 1024 + c0) = w0; *(u32x4*)(hout + (size_t)row * 1024 + c1) = w1;
        if (h8) { u32x2 a, bq; a.x = pk4_fp8(v[0], v[1], v[2], v[3]); a.y = pk4_fp8(v[4], v[5], v[6], v[7]); bq.x = pk4_fp8(v[8], v[9], v[10], v[11]); bq.y = pk4_fp8(v[12], v[13], v[14], v[15]);
            *(u32x2*)(h8 + (size_t)row * 1024 + c0) = a; *(u32x2*)(h8 + (size_t)row * 1024 + c1) = bq; }
        if (final && !dry) { float* o = p.out + (size_t)row * 1024;
            *(f32x4*)(o + c0) = (f32x4){v[0], v[1], v[2], v[3]}; *(f32x4*)(o + c0 + 4) = (f32x4){v[4], v[5], v[6], v[7]};
            *(f32x4*)(o + c1) = (f32x4){v[8], v[9], v[10], v[11]}; *(f32x4*)(o + c1 + 4) = (f32x4){v[12], v[13], v[14], v[15]}; }
    }
    asm volatile("" :: "v"(dmy0), "v"(dmy1));
#undef LN_SLOTS
#undef LN_FETCH
}

template <int K> __device__ __forceinline__ float quad_bcast(float v) { return __int_as_float(__builtin_amdgcn_update_dpp(0, __float_as_int(v), K * 0x55, 0xf, 0xf, false)); }
constexpr int HG_QI = 0, HG_KI = 4352, HG_KIT = 8704  , HG_VT = 8704  , HG_EB0 = 16896, HG_EE = 17408, HG_BUF = 17920, HG_OB = 2 * HG_BUF, HG_OBSZ = 16 * 132 * 4, HG_VROW = 16;
__device__ __forceinline__ void hgrn_scan_phase(const Params& p, LAS unsigned char* lds, int j) {
    LAUNDER_IDS();
    unsigned char* ws = p.ws;
    const bf16_t* Qb = (const bf16_t*)(ws + WS_BIG + BA_Q); const bf16_t* E1b = (const bf16_t*)(ws + WS_BIG + BA_E1); const bf16_t* KIb = (const bf16_t*)(ws + WS_BIG + BA_KI);
    const bf16_t* VTb = (const bf16_t*)(ws + WS_BIG + BA_VT); const bf16_t* Gb = (const bf16_t*)(ws + WS_BIG + BA_G); const float* HGSb = (const float*)(ws + WS_HGS);
    bf16_t* T0 = (bf16_t*)(ws + WS_T0);
    const int tid = TIDX, lane = tid & 63, wave = __builtin_amdgcn_readfirstlane(tid >> 6), fr = lane & 15, fq = lane >> 4;
    const bool mfma_role = wave < 4;
    const int pt = tid & 255, ptok = pt >> 4, pc8 = (pt & 15) * 8;
    if (j == 0 && GDIMX > 128 && BIDX >= 128) {
        conv_group8(lds, p.in[25] + (size_t)96 * 1024 * 2048, ws + WS_W1 + (size_t)96 * 2048 * 1024, 32, 2048, 2, 64.0f, BIDX - 128, GDIMX - 128);
        conv_group8(lds, p.in[27] + (size_t)96 * 1024 * 1024, ws + WS_W2 + (size_t)96 * 1024 * 1024, 32, 1024, 0, 64.0f, BIDX - 128, GDIMX - 128);
        return; }
    if (j == 0 && GDIMX <= 128) {
        conv_group8(lds, p.in[25] + (size_t)96 * 1024 * 2048, ws + WS_W1 + (size_t)96 * 2048 * 1024, 32, 2048, 2, 64.0f);
        conv_group8(lds, p.in[27] + (size_t)96 * 1024 * 1024, ws + WS_W2 + (size_t)96 * 1024 * 1024, 32, 1024, 0, 64.0f); }
    for (int unit = BIDX; unit < 128; unit += GDIMX) {
        const int b = unit >> 3, hd = unit & 7;
        const size_t base = (size_t)b * SEQ * 1024 + hd * 128;
        if (mfma_role) {
            f32x4 S[8][2];
#pragma unroll
            for (int i = 0; i < 8; ++i) { S[i][0] = (f32x4){0.f, 0.f, 0.f, 0.f}; S[i][1] = (f32x4){0.f, 0.f, 0.f, 0.f}; }
            __syncthreads();
            for (int step = 0; step < 256; ++step) {
                const int cb = step & 1; LAS unsigned char* hb = lds + cb * HG_BUF;
                const LAS bf16_t* qi = (const LAS bf16_t*)(hb + HG_QI); const LAS bf16_t* ki = (const LAS bf16_t*)(hb + HG_KI);
                const LAS bf16_t* vT = (const LAS bf16_t*)(hb + HG_VT);
                const LAS float* eb0 = (const LAS float*)(hb + HG_EB0); const LAS float* ee = (const LAS float*)(hb + HG_EE);
                LAS float* ob = (LAS float*)(lds + HG_OB + cb * HG_OBSZ);
                f32x4 at = {0.f, 0.f, 0.f, 0.f};
#pragma unroll
                for (int kk = 0; kk < 4; ++kk) { const bf16x8 kf = *(const LAS bf16x8*)(ki + fr * 136 + 32 * kk + 8 * fq), qf = *(const LAS bf16x8*)(qi + fr * 136 + 32 * kk + 8 * fq); at = mfma32(kf, qf, at); }
#pragma unroll
                for (int r = 0; r < 4; ++r) if (4 * fq + r > fr) at[r] = 0.f;
                const bf16x4 pa = mk4f(at);
                bf16x4 vf[2];
#pragma unroll
                for (int nt = 0; nt < 2; ++nt) vf[nt] = __builtin_amdgcn_ds_read_tr16_b64_v4i16((LAS bf16x4*)(vT + (4 * fq + (fr >> 2)) * 136 + 32 * wave + 16 * nt + 4 * (fr & 3)));
#pragma unroll
                for (int i = 0; i < 8; ++i) { const f32x4 e0 = *(const LAS f32x4*)(eb0 + 16 * i + 4 * fq); S[i][0] = S[i][0] * e0; S[i][1] = S[i][1] * e0; }
                f32x4 o[2];
#pragma unroll
                for (int nt = 0; nt < 2; ++nt) { o[nt] = (f32x4){0.f, 0.f, 0.f, 0.f}; o[nt] = mfma16(pa, vf[nt], o[nt]); }
#pragma unroll
                for (int kk = 0; kk < 4; ++kk) {
                    const u32x2 qa = *(const LAS u32x2*)(qi + fr * 136 + 32 * kk + 4 * fq), qb = *(const LAS u32x2*)(qi + fr * 136 + 32 * kk + 16 + 4 * fq);
                    const bf16x8 qp = mk8(qa, qb);
#pragma unroll
                    for (int nt = 0; nt < 2; ++nt) o[nt] = mfma32(qp, mk8f(S[2 * kk][nt], S[2 * kk + 1][nt]), o[nt]); }
#pragma unroll
                for (int nt = 0; nt < 2; ++nt)
#pragma unroll
                    for (int r = 0; r < 4; ++r) ob[(4 * fq + r) * 132 + 32 * wave + 16 * nt + fr] = o[nt][r];
#pragma unroll
                for (int i = 0; i < 8; ++i) { const bf16x4 kf = __builtin_amdgcn_ds_read_tr16_b64_v4i16((LAS bf16x4*)(ki + (4 * fq + (fr >> 2)) * 136 + 16 * i + 4 * (fr & 3)));
                    const f32x4 e1 = *(const LAS f32x4*)(ee + 16 * i + 4 * fq);
#pragma unroll
                    for (int nt = 0; nt < 2; ++nt) S[i][nt] = mfma16(kf, vf[nt], S[i][nt]) * e1; }
                __syncthreads();
            }
            __syncthreads();
        } else {
            __builtin_amdgcn_s_setprio(2);
            f32x4 ngv[2]; ngv[0] = *(const f32x4*)(p.in[7] + (size_t)j * 1024 + hd * 128 + pc8); ngv[1] = *(const f32x4*)(p.in[7] + (size_t)j * 1024 + hd * 128 + pc8 + 4);
            u32x4 pq[4], pe1[4], pki[4], pv[4], pg[4]; f32x4 psm[4];
#define HG_LOAD(slot_, step_) do { { const int st_ = (step_) < 256 ? (step_) : 255;     \
                const size_t o_ = base + (size_t)(st_ * 16 + ptok) * 1024 + pc8; \
                pq[slot_] = *(const u32x4*)(Qb + o_); pe1[slot_] = *(const u32x4*)(E1b + o_); pki[slot_] = *(const u32x4*)(KIb + o_); \
                pv[slot_] = *(const u32x4*)(VTb + o_); \
                psm[slot_] = *(const f32x4*)(HGSb + (size_t)(1 + ((pt >> 5) & 1)) * (HGS1 / 4) + (size_t)(b * 256 + st_) * 1024 + hd * 128 + (pt & 31) * 4); } } while (0)
#define HG_LOADG(slot_, step_) do { const int st_ = (step_) < 256 ? (step_) : 255; pg[slot_] = *(const u32x4*)(Gb + base + (size_t)(st_ * 16 + ptok) * 1024 + pc8); } while (0)
#define HG_STAGE1(B_, slot_) do { LAS unsigned char* hb_ = lds + (B_) * HG_BUF; u32x4 qiw_; \
                _Pragma("unroll") for (int e = 0; e < 4; ++e) qiw_[e] = pk2(lo16(pq[slot_][e]) * lo16(pe1[slot_][e]), hi16(pq[slot_][e]) * hi16(pe1[slot_][e])); \
                *(LAS u32x4*)(hb_ + HG_QI + (ptok * 136 + pc8) * 2) = qiw_; \
                *(LAS u32x4*)(hb_ + HG_KI + (ptok * 136 + pc8) * 2) = pki[slot_]; \
                *(LAS u32x4*)(hb_ + HG_VT + (ptok * 136 + pc8) * 2) = pv[slot_]; \
                *(LAS f32x4*)(hb_ + HG_EB0 + (pt & 63) * 16) = psm[slot_]; } while (0)
#define HG_STAGE3(step_, slot_) do { const LAS float* ob_ = (const LAS float*)(lds + HG_OB + ((step_) & 1) * HG_OBSZ); \
                const f32x4 x0_ = *(const LAS f32x4*)(ob_ + ptok * 132 + pc8), x1_ = *(const LAS f32x4*)(ob_ + ptok * 132 + pc8 + 4); \
                float ss_ = (x0_[0] * x0_[0] + x0_[1] * x0_[1]) + (x0_[2] * x0_[2] + x0_[3] * x0_[3]) + (x1_[0] * x1_[0] + x1_[1] * x1_[1]) + (x1_[2] * x1_[2] + x1_[3] * x1_[3]); \
                ss_ += __int_as_float(__builtin_amdgcn_update_dpp(0, __float_as_int(ss_), 0x128, 0xf, 0xf, false)); \
                ss_ += __int_as_float(__builtin_amdgcn_update_dpp(0, __float_as_int(ss_), 0x124, 0xf, 0xf, false)); \
                ss_ += __int_as_float(__builtin_amdgcn_update_dpp(0, __float_as_int(ss_), 0x122, 0xf, 0xf, false)); \
                ss_ += __int_as_float(__builtin_amdgcn_update_dpp(0, __float_as_int(ss_), 0x121, 0xf, 0xf, false)); \
                const float rr_ = rsqrtf(ss_ * (1.0f / 128.0f) + LN_EPS); const u32x4 gw_ = pg[slot_]; u32x4 w_; \
                w_.x = pk2(x0_[0] * rr_ * ngv[0][0] * lo16(gw_.x), x0_[1] * rr_ * ngv[0][1] * hi16(gw_.x)); w_.y = pk2(x0_[2] * rr_ * ngv[0][2] * lo16(gw_.y), x0_[3] * rr_ * ngv[0][3] * hi16(gw_.y)); \
                w_.z = pk2(x1_[0] * rr_ * ngv[1][0] * lo16(gw_.z), x1_[1] * rr_ * ngv[1][1] * hi16(gw_.z)); w_.w = pk2(x1_[2] * rr_ * ngv[1][2] * lo16(gw_.w), x1_[3] * rr_ * ngv[1][3] * hi16(gw_.w)); \
                if (FP8_MIXOUT) { u32x2 w8_; w8_.x = pk4_fp8(lo16(w_.x), hi16(w_.x), lo16(w_.y), hi16(w_.y)); w8_.y = pk4_fp8(lo16(w_.z), hi16(w_.z), lo16(w_.w), hi16(w_.w)); \
                    *(u32x2*)((unsigned char*)T0 + base + (size_t)((step_) * 16 + ptok) * 1024 + pc8) = w8_; } \
                else *(u32x4*)(T0 + base + (size_t)((step_) * 16 + ptok) * 1024 + pc8) = w_; } while (0)
#define HG_PBODY(step_, U_) do { \
                if ((step_) + 1 < 256) HG_STAGE1(((U_) + 1) & 1, ((U_) + 1) & 3); \
                HG_LOAD(((U_) + 1) & 3, (step_) + 5); \
                if ((step_) > 0) HG_STAGE3((step_) - 1, ((U_) + 3) & 3); \
                HG_LOADG(((U_) + 3) & 3, (step_) + 3); \
                __syncthreads(); } while (0)
            HG_LOAD(0, 0); HG_LOAD(1, 1); HG_LOAD(2, 2); HG_LOAD(3, 3);
            HG_LOADG(0, 0); HG_LOADG(1, 1); HG_LOADG(2, 2);
            HG_STAGE1(0, 0);
            HG_LOAD(0, 4);
            __syncthreads();
            for (int s4 = 0; s4 < 256; s4 += 4) { HG_PBODY(s4, 0); HG_PBODY(s4 + 1, 1); HG_PBODY(s4 + 2, 2); HG_PBODY(s4 + 3, 3); }
            HG_STAGE3(255, 3);
            __syncthreads();
            __builtin_amdgcn_s_setprio(0);
#undef HG_LOAD
#undef HG_LOADG
#undef HG_STAGE1
#undef HG_STAGE3
#undef HG_PBODY
        }
    }
}

__device__ __forceinline__ void s5_phase(const Params& p, LAS unsigned char* lds) {
    LAUNDER_IDS();
    unsigned char* ws = p.ws;
    const int tid = TIDX, lane = tid & 63, wave = tid >> 6, fr = lane & 15, fq = lane >> 4;
    if (wave >= 4) return;
    const bf16_t* h = (const bf16_t*)(ws + WS_H); bf16_t* T0 = (bf16_t*)(ws + WS_T0);
    LAS float* BU = (LAS float*)(lds + wave * 16384);
    LAS bf16_t* XT = (LAS bf16_t*)(lds + wave * 16384 + 8448);
    for (int task = BIDX * 4 + wave; task < 1024; task += GDIMX * 4) {
        int b = task >> 6, g = task & 63;
        if (GDIMX == 256) { const int xq = BIDX & 7, yq = BIDX >> 3; b = 2 * xq + (yq >> 4); g = (yq & 15) * 4 + wave; }
        const float* lam = (const float*)(ws + WS_S5LAM) + (size_t)(g * 64 + lane) * 2; const float lr = lam[0], li = lam[1];
        bf16x8 bf[8], cf[4];
        const bf16x8 zero8 = {0, 0, 0, 0, 0, 0, 0, 0};
#pragma unroll
        for (int t = 0; t < 8; ++t) bf[t] = fq < 2 ? *(const bf16x8*)((const bf16_t*)(ws + WS_S5BT) + (size_t)(g * 128 + 16 * t + fr) * 16 + 8 * fq) : zero8;
#pragma unroll
        for (int kk = 0; kk < 4; ++kk) cf[kk] = *(const bf16x8*)((const bf16_t*)(ws + WS_S5C) + (size_t)(g * 16 + fr) * 128 + 32 * kk + 8 * fq);
        float dsk[4];
#pragma unroll
        for (int r = 0; r < 4; ++r) dsk[r] = p.in[18][g * 16 + 4 * fq + r];
        f32x2 xv = {0.f, 0.f}; const f32x2 cl = {lr, lr}, cn = {-li, li};
        const size_t base = (size_t)b * SEQ * 1024 + g * 16;
        u32x4 nu = *(const u32x4*)(h + base + (size_t)fr * 1024 + 8 * (fq & 1));
        u32x2 ns = *(const u32x2*)(h + base + (size_t)fr * 1024 + 4 * fq);
        const unsigned dmy = h[base + 16 + fr];
        for (int tb = 0; tb < 256; ++tb) {
            asm volatile("" : "+v"(nu), "+v"(ns));
            const bf16x8 cu = fq >= 2 ? zero8 : __builtin_bit_cast(bf16x8, nu); const u32x2 cs = ns;
            { const size_t nb_ = base + (size_t)(tb + 1 < 256 ? tb + 1 : 255) * 16 * 1024;
                nu = *(const u32x4*)(h + nb_ + (size_t)fr * 1024 + 8 * (fq & 1));
                ns = *(const u32x2*)(h + nb_ + (size_t)fr * 1024 + 4 * fq); }
#pragma unroll
            for (int t = 0; t < 8; ++t) { f32x4 a = {0.f, 0.f, 0.f, 0.f}; a = mfma32(cu, bf[t], a);
#pragma unroll
                for (int r = 0; r < 4; ++r) BU[(4 * fq + r) * 132 + 16 * t + fr] = a[r]; }
            asm volatile("s_waitcnt lgkmcnt(0)" ::: "memory"); __builtin_amdgcn_wave_barrier();
            { f32x2 bb[16];
#pragma unroll
                for (int t = 0; t < 16; ++t) { bb[t].x = BU[t * 132 + lane]; bb[t].y = BU[t * 132 + 64 + lane]; }
                asm volatile("" : "+v"(bb[0]), "+v"(bb[1]), "+v"(bb[2]), "+v"(bb[3]), "+v"(bb[4]), "+v"(bb[5]), "+v"(bb[6]), "+v"(bb[7]), "+v"(bb[8]), "+v"(bb[9]), "+v"(bb[10]), "+v"(bb[11]), "+v"(bb[12]), "+v"(bb[13]), "+v"(bb[14]), "+v"(bb[15]));
                f32x2 xa[16];
#pragma unroll
                for (int t = 0; t < 16; ++t) {
                    const f32x2 tt = __builtin_elementwise_fma(cn, xv.yx, bb[t]);
                    xv = __builtin_elementwise_fma(cl, xv, tt); xa[t] = xv; }
#pragma unroll
                for (int h = 0; h < 2; ++h) { u32x4 wr, wi;
#pragma unroll
                    for (int e = 0; e < 4; ++e) { wr[e] = pk2(xa[8 * h + 2 * e].x, xa[8 * h + 2 * e + 1].x); wi[e] = pk2(xa[8 * h + 2 * e].y, xa[8 * h + 2 * e + 1].y); }
                    *(LAS u32x4*)(XT + lane * 24 + 8 * h) = wr; *(LAS u32x4*)(XT + (64 + lane) * 24 + 8 * h) = wi; } }
            asm volatile("s_waitcnt lgkmcnt(0)" ::: "memory"); __builtin_amdgcn_wave_barrier();
            f32x4 acc = {0.f, 0.f, 0.f, 0.f};
#pragma unroll
            for (int kk = 0; kk < 4; ++kk) {
                const bf16x4 xa_ = __builtin_amdgcn_ds_read_tr16_b64_v4i16((LAS bf16x4*)(XT + (32 * kk + 8 * fq + (fr >> 2)) * 24 + 4 * (fr & 3)));
                const bf16x4 xb_ = __builtin_amdgcn_ds_read_tr16_b64_v4i16((LAS bf16x4*)(XT + (32 * kk + 8 * fq + 4 + (fr >> 2)) * 24 + 4 * (fr & 3)));
                const bf16x8 xf = __builtin_shufflevector(xa_, xb_, 0, 1, 2, 3, 4, 5, 6, 7); acc = mfma32(cf[kk], xf, acc); }
            { static_assert(FP8_GLU, "the S5 mixer output is stored as e4m3");
                const float y0 = acc[0] + dsk[0] * lo16(cs.x), y1 = acc[1] + dsk[1] * hi16(cs.x), y2 = acc[2] + dsk[2] * lo16(cs.y), y3 = acc[3] + dsk[3] * hi16(cs.y);
                *(unsigned*)((unsigned char*)T0 + base + (size_t)(tb * 16 + fr) * 1024 + 4 * fq) = pk4_fp8(gelu_tanh(y0), gelu_tanh(y1), gelu_tanh(y2), gelu_tanh(y3)); }
            asm volatile("s_waitcnt lgkmcnt(0)" ::: "memory"); __builtin_amdgcn_wave_barrier();
        }
        asm volatile("" :: "v"(dmy));
    }
}

constexpr int DK_ROW = 72, DV_ROW = 136, DK_SLOT = 128 * DK_ROW * 2, DV_SLOT = 64 * DV_ROW * 2, DV_OFF = 3 * DK_SLOT;
__device__ __forceinline__ void dl_desc(int i, int& g, int& dl, int& r, int& n) {
    if (i < 32) { g = 0; dl = 1; r = 0; n = i; } else if (i < 64) { g = 1; dl = 4; r = (i - 32) >> 3; n = (i - 32) & 7; } else { g = 2; dl = 16; r = (i - 64) >> 1; n = (i - 64) & 1; } }
__device__ __forceinline__ void dilated_bh(const bf16_t* proj, bf16_t* og, float* lse, LAS unsigned char* lds, int tid, int b, int head) {
    const int lane = tid & 63, wave = tid >> 6, fr = lane & 15, fq = lane >> 4;
    const size_t tok0 = (size_t)b * SEQ;
    const int srow = tid >> 3, sc = tid & 7;
    const int vk = (tid >> 3) * 2, vc = tid & 7;
    const int vrow = 32 * (vc & 1) + 4 * (vc >> 1);
    const int qi_ = 16 * wave + fr;
    u32x2 fk0[3], fk1[3], fv0[3], fv1[3], fq0[3], fq1[3];
    const unsigned char* proj8 = (const unsigned char*)proj;
#define DL_FETCH(u_, i_) do { int g_, dl_, r_, n_; dl_desc((i_) < 96 ? (i_) : 95, g_, dl_, r_, n_);     \
        const size_t t0_ = tok0 + ((size_t)n_ * 128) * dl_ + r_; const size_t qc_ = (size_t)g_ * 3072 + head * 64; \
        fk0[u_] = *(const u32x2*)(proj8 + (t0_ + (size_t)srow * dl_) * 9216 + qc_ + 1024 + sc * 8); fk1[u_] = *(const u32x2*)(proj8 + (t0_ + (size_t)(srow + 64) * dl_) * 9216 + qc_ + 1024 + sc * 8); \
        fv0[u_] = *(const u32x2*)(proj8 + (t0_ + (size_t)vk * dl_) * 9216 + qc_ + 2048 + vc * 8); fv1[u_] = *(const u32x2*)(proj8 + (t0_ + (size_t)(vk + 1) * dl_) * 9216 + qc_ + 2048 + vc * 8); \
        const size_t qt_ = t0_ + (size_t)qi_ * dl_; fq0[u_] = *(const u32x2*)(proj8 + qt_ * 9216 + qc_ + 8 * fq); fq1[u_] = *(const u32x2*)(proj8 + qt_ * 9216 + qc_ + 32 + 8 * fq); } while (0)
#define DL_STORE(u_) do { LAS unsigned char* ks_ = lds + (u_) * DK_SLOT; LAS unsigned char* vs_ = lds + DV_OFF + (u_) * DV_SLOT;     \
        const u32x4 rk0 = f8x8_to_bf16x8(fk0[u_]), rk1 = f8x8_to_bf16x8(fk1[u_]), rv0 = f8x8_to_bf16x8(fv0[u_]), rv1 = f8x8_to_bf16x8(fv1[u_]); \
        *(LAS u32x4*)(ks_ + (srow * DK_ROW + sc * 8) * 2) = rk0; *(LAS u32x4*)(ks_ + ((srow + 64) * DK_ROW + sc * 8) * 2) = rk1; \
        _Pragma("unroll") for (int e = 0; e < 4; ++e) { \
            *(LAS unsigned*)(vs_ + ((vrow + 16 * (e >> 1) + 2 * (e & 1)) * DV_ROW + vk) * 2) = (rv0[e] & 0xffffu) | (rv1[e] << 16); \
            *(LAS unsigned*)(vs_ + ((vrow + 16 * (e >> 1) + 2 * (e & 1) + 1) * DV_ROW + vk) * 2) = (rv0[e] >> 16) | (rv1[e] & 0xffff0000u); } } while (0)
    __syncthreads();
    DL_FETCH(0, 0); DL_FETCH(1, 1); DL_FETCH(2, 2);
    DL_STORE(0);
    __syncthreads();
    for (int i3 = 0; i3 < 96; i3 += 3) {
#pragma unroll
        for (int u = 0; u < 3; ++u) {
            const int i = i3 + u; int g, dl, r, n; dl_desc(i, g, dl, r, n);
            bf16x8 qf[2]; qf[0] = __builtin_bit_cast(bf16x8, f8x8_to_bf16x8(fq0[u])); qf[1] = __builtin_bit_cast(bf16x8, f8x8_to_bf16x8(fq1[u]));
            DL_FETCH(u, i + 3);
            const int cs = u, ps = n == 0 ? cs : (u + 2) % 3;
            const size_t qtok = tok0 + (size_t)(n * 128 + qi_) * dl + r;
            f32x4 st[10]; float mx = -3.0e38f;
#pragma unroll
            for (int k = 0; k < 9; ++k) { int t = wave + k; const bool tok = t <= 15 && (n > 0 || t >= 8); t = t > 15 ? 15 : t;
                const LAS unsigned char* kb = lds + ((t < 8) ? ps : cs) * DK_SLOT + ((t & 7) * 16 + fr) * (DK_ROW * 2) + fq * 16;
                f32x4 a = {0.f, 0.f, 0.f, 0.f};
#pragma unroll
                for (int kk = 0; kk < 2; ++kk) a = mfma32(*(const LAS bf16x8*)(kb + kk * 64), qf[kk], a);
                if (k == 0 || k == 8) {
#pragma unroll
                    for (int e = 0; e < 4; ++e) { const bool valid = tok && (k == 0 ? 4 * fq + e >= fr : 4 * fq + e <= fr); a[e] = valid ? a[e] : -1.0e30f; } }
                else if (!tok) a = (f32x4){-1.0e30f, -1.0e30f, -1.0e30f, -1.0e30f};
#pragma unroll
                for (int e = 0; e < 4; ++e) mx = fmaxf(mx, a[e]);
                st[k] = a; }
            mx = fmaxf(mx, __shfl_xor(mx, 16)); mx = fmaxf(mx, __shfl_xor(mx, 32));
            float sum = 0.f; const float esc = 0.125f * 1.4426950408889634f, eoff = -mx * esc;
#pragma unroll
            for (int k = 0; k < 9; ++k)
#pragma unroll
                for (int e = 0; e < 4; ++e) { const float pe = __builtin_amdgcn_exp2f(__builtin_fmaf(st[k][e], esc, eoff)); st[k][e] = pe; sum += pe; }
            st[9] = (f32x4){0.f, 0.f, 0.f, 0.f};
            sum += __shfl_xor(sum, 16); sum += __shfl_xor(sum, 32);
            f32x4 ot[4];
#pragma unroll
            for (int dt = 0; dt < 4; ++dt) ot[dt] = (f32x4){0.f, 0.f, 0.f, 0.f};
#pragma unroll
            for (int kk = 0; kk < 5; ++kk) { const bf16x8 pf = mk8f(st[2 * kk], st[2 * kk + 1]);
                int ta = wave + 2 * kk, tb = ta + 1; ta = ta > 15 ? 15 : ta; tb = tb > 15 ? 15 : tb;
                const LAS unsigned char* va_ = lds + DV_OFF + ((ta < 8) ? ps : cs) * DV_SLOT + (fr * DV_ROW + (ta & 7) * 16 + 4 * fq) * 2;
                const LAS unsigned char* vb_ = lds + DV_OFF + ((tb < 8) ? ps : cs) * DV_SLOT + (fr * DV_ROW + (tb & 7) * 16 + 4 * fq) * 2;
#pragma unroll
                for (int dt = 0; dt < 4; ++dt) { const u32x2 va = *(const LAS u32x2*)(va_ + dt * 16 * DV_ROW * 2), vb = *(const LAS u32x2*)(vb_ + dt * 16 * DV_ROW * 2);
                    ot[dt] = mfma32(mk8(va, vb), pf, ot[dt]); } }
            const float inv = __builtin_amdgcn_rcpf(sum); u32x4 ow;
#pragma unroll
            for (int dt = 0; dt < 4; ++dt) ow[dt] = pk4_fp8(ot[dt][0] * inv, ot[dt][1] * inv, ot[dt][2] * inv, ot[dt][3] * inv);
            *(u32x4*)((unsigned char*)og + qtok * 3072 + g * 1024 + head * 64 + 16 * fq) = ow;
            lse[qtok * 48 + g * 16 + head] = mx * 0.125f + __logf(sum);
            if (i + 1 < 96) DL_STORE((u + 1) % 3);
            __syncthreads();
        }
    }
#undef DL_FETCH
#undef DL_STORE
}
__device__ __forceinline__ void dilated_attn_phase(const Params& p, LAS unsigned char* lds) {
    LAUNDER_IDS();
    unsigned char* ws = p.ws;
    const bf16_t* proj = (const bf16_t*)(ws + WS_BIG + BB_PROJ); bf16_t* og = (bf16_t*)(ws + WS_BIG + BB_OG); float* lse = (float*)(ws + WS_LSE); bf16_t* T0 = (bf16_t*)(ws + WS_T0);
    const int tid = TIDX;
    for (int bh = BIDX; bh < 256; bh += GDIMX) {
        const int xq = bh & 7, yq = bh >> 3; const int b = GDIMX == 256 ? 2 * xq + (yq >> 4) : bh >> 4, head = GDIMX == 256 ? (yq & 15) : (bh & 15);
        dilated_bh(proj, og, lse, lds, tid, b, head);
        asm volatile("s_waitcnt vmcnt(0)" ::: "memory"); __syncthreads(); __builtin_amdgcn_fence(__ATOMIC_ACQUIRE, "agent"); asm volatile("s_waitcnt vmcnt(0)" ::: "memory");
        const int c8 = head * 64 + (tid & 7) * 8; const unsigned char* og8 = (const unsigned char*)og;
        for (int i0 = 0; i0 < 64; i0 += 8) {
            float l0[8], l1[8], l2[8]; u32x2 a[8], bq[8], c[8];
#pragma unroll
            for (int u = 0; u < 8; ++u) { const size_t tok = (size_t)b * SEQ + (i0 + u) * 64 + (tid >> 3);
                l0[u] = lse[tok * 48 + head]; l1[u] = lse[tok * 48 + 16 + head]; l2[u] = lse[tok * 48 + 32 + head];
                a[u] = *(const u32x2*)(og8 + tok * 3072 + c8); bq[u] = *(const u32x2*)(og8 + tok * 3072 + 1024 + c8); c[u] = *(const u32x2*)(og8 + tok * 3072 + 2048 + c8); }
#pragma unroll
            for (int u = 0; u < 8; ++u) { const size_t tok = (size_t)b * SEQ + (i0 + u) * 64 + (tid >> 3);
                const float m = fmaxf(l0[u], fmaxf(l1[u], l2[u])); float w0 = __expf(l0[u] - m), w1 = __expf(l1[u] - m), w2 = __expf(l2[u] - m); const float inv = __builtin_amdgcn_rcpf(w0 + w1 + w2); w0 *= inv; w1 *= inv; w2 *= inv;
                u32x4 w;
#pragma unroll
                for (int e = 0; e < 4; ++e) { const f32x2 fa = (e & 1) ? fp8x2_hi(a[u][e >> 1]) : fp8x2_lo(a[u][e >> 1]), fb = (e & 1) ? fp8x2_hi(bq[u][e >> 1]) : fp8x2_lo(bq[u][e >> 1]), fc = (e & 1) ? fp8x2_hi(c[u][e >> 1]) : fp8x2_lo(c[u][e >> 1]);
                    w[e] = pk2(w0 * fa.x + w1 * fb.x + w2 * fc.x, w0 * fa.y + w1 * fb.y + w2 * fc.y); }
                if (FP8_MIXOUT || FP8_DILOUT) { u32x2 w8; w8.x = pk4_fp8(lo16(w[0]), hi16(w[0]), lo16(w[1]), hi16(w[1])); w8.y = pk4_fp8(lo16(w[2]), hi16(w[2]), lo16(w[3]), hi16(w[3])); *(u32x2*)((unsigned char*)T0 + tok * 1024 + c8) = w8; }
                else *(u32x4*)(T0 + tok * 1024 + c8) = w; } }
    }
}

constexpr int XROW = 528;
__device__ __forceinline__ void cross_stage(LAS unsigned char* lds, const bf16_t* src, unsigned row_stride_bytes, int tid) {
    const unsigned goff = (unsigned)(tid >> 5) * row_stride_bytes + (unsigned)(tid & 31) * 16u;
    LAS unsigned char* dst = lds + (tid >> 5) * XROW + (tid & 31) * 16;
#pragma unroll
    for (int h = 0; h < 2; ++h) { u32x4 v[8];
#pragma unroll
        for (int i = 0; i < 8; ++i) v[i] = *(const u32x4*)((const unsigned char*)src + (size_t)(h * 8 + i) * 16 * row_stride_bytes + goff);
#pragma unroll
        for (int i = 0; i < 8; ++i) *(LAS u32x4*)(dst + (h * 8 + i) * 16 * XROW) = v[i]; }
}
__device__ __forceinline__ void cross_attn_phase(const Params& p, LAS unsigned char* lds) {
    LAUNDER_IDS();
    unsigned char* ws = p.ws;
    const bf16_t* qm = (const bf16_t*)(ws + WS_T0); const bf16_t* Km = (const bf16_t*)(ws + WS_KMEM); const bf16_t* VT = (const bf16_t*)(ws + WS_VTMEM); bf16_t* O = (bf16_t*)(ws + WS_T1);
    const int tid = TIDX, lane = tid & 63, wave = tid >> 6, fr = lane & 15, fq = lane >> 4;
    LAS unsigned char* kbase = lds + fr * XROW + fq * 16;
    LAS unsigned char* vbase = lds + fr * XROW + fq * 8;
    for (int unit = BIDX; unit < 16 * 4 * 16; unit += GDIMX) {
        int qt = unit & 15, head = (unit >> 4) & 3, b = unit >> 6;
        if (GDIMX == 256) { const int xq = BIDX & 7, yq = BIDX >> 3, gi = (unit >> 8) * 16 + xq * 2 + (yq >> 4); qt = yq & 15; head = gi & 3; b = gi >> 2; }
        const size_t tokq = (size_t)b * SEQ + qt * 256 + 32 * wave + fr;
        __syncthreads();
        cross_stage(lds, Km + (size_t)(b * 256) * 1024 + head * 256, 2048u, tid);
        const unsigned char* qm8 = (const unsigned char*)qm;
        bf16x8 qf[8];
#pragma unroll
        for (int kk = 0; kk < 8; ++kk) qf[kk] = __builtin_bit_cast(bf16x8, f8x8_to_bf16x8(*(const u32x2*)(qm8 + tokq * 1024 + head * 256 + 32 * kk + 8 * fq)));
        __syncthreads();
        bf16x8 pf[2][8];
#pragma unroll
        for (int g = 0; g < 2; ++g) {
            f32x4 st[16]; float mx = -3.0e38f;
            bf16x8 kf[2][8];
#pragma unroll
            for (int kk = 0; kk < 8; ++kk) kf[0][kk] = *(const LAS bf16x8*)(kbase + kk * 64);
            __builtin_amdgcn_sched_barrier(0);
#pragma unroll
            for (int t = 0; t < 16; ++t) { f32x4 a = {0.f, 0.f, 0.f, 0.f};
                if (t + 1 < 16) {
#pragma unroll
                    for (int kk = 0; kk < 8; ++kk) kf[(t + 1) & 1][kk] = *(const LAS bf16x8*)(kbase + (t + 1) * (16 * XROW) + kk * 64); }
#pragma unroll
                for (int kk = 0; kk < 8; ++kk) a = mfma32(kf[t & 1][kk], qf[kk], a);
#pragma unroll
                for (int e = 0; e < 4; ++e) mx = fmaxf(mx, a[e]);
                st[t] = a;
                __builtin_amdgcn_sched_barrier(0); }
            if (g == 0) {
#pragma unroll
                for (int kk = 0; kk < 8; ++kk) qf[kk] = __builtin_bit_cast(bf16x8, f8x8_to_bf16x8(*(const u32x2*)(qm8 + (tokq + 16) * 1024 + head * 256 + 32 * kk + 8 * fq))); }
            mx = fmaxf(mx, __shfl_xor(mx, 16)); mx = fmaxf(mx, __shfl_xor(mx, 32));
            float sum = 0.f; const float esc = 0.0625f * 1.4426950408889634f, eoff = -mx * esc;
#pragma unroll
            for (int t = 0; t < 16; ++t)
#pragma unroll
                for (int e = 0; e < 4; ++e) { const float pe = __builtin_amdgcn_exp2f(__builtin_fmaf(st[t][e], esc, eoff)); st[t][e] = pe; sum += pe; }
            sum += __shfl_xor(sum, 16); sum += __shfl_xor(sum, 32);
            const float inv = __builtin_amdgcn_rcpf(sum);
#pragma unroll
            for (int kk = 0; kk < 8; ++kk) pf[g][kk] = mk8f(st[2 * kk] * inv, st[2 * kk + 1] * inv);
        }
        __syncthreads();
        cross_stage(lds, VT + (size_t)(head * 256) * 4096 + b * 256, 8192u, tid);
        __syncthreads();
        u32x2 vfa[2][8], vfb[2][8];
        u32x4 ow0, ow1;
#pragma unroll
        for (int kk = 0; kk < 8; ++kk) { vfa[0][kk] = *(const LAS u32x2*)(vbase + kk * 64); vfb[0][kk] = *(const LAS u32x2*)(vbase + kk * 64 + 32); }
        __builtin_amdgcn_sched_barrier(0);
#pragma unroll
        for (int dt = 0; dt < 16; ++dt) { f32x4 o0 = {0.f, 0.f, 0.f, 0.f}, o1 = {0.f, 0.f, 0.f, 0.f};
            if (dt + 1 < 16) {
#pragma unroll
                for (int kk = 0; kk < 8; ++kk) { vfa[(dt + 1) & 1][kk] = *(const LAS u32x2*)(vbase + (dt + 1) * (16 * XROW) + kk * 64); vfb[(dt + 1) & 1][kk] = *(const LAS u32x2*)(vbase + (dt + 1) * (16 * XROW) + kk * 64 + 32); } }
#pragma unroll
            for (int kk = 0; kk < 8; ++kk) { const bf16x8 vf = mk8(vfa[dt & 1][kk], vfb[dt & 1][kk]); o0 = mfma32(vf, pf[0][kk], o0); o1 = mfma32(vf, pf[1][kk], o1); }
            __builtin_amdgcn_sched_barrier(0);
#if FP8_O
            ow0[dt & 3] = pk4_fp8(o0[0], o0[1], o0[2], o0[3]); ow1[dt & 3] = pk4_fp8(o1[0], o1[1], o1[2], o1[3]);
            if ((dt & 3) == 3) { *(u32x4*)((unsigned char*)O + tokq * 1024 + head * 256 + 64 * fq + 16 * (dt >> 2)) = ow0;
                *(u32x4*)((unsigned char*)O + (tokq + 16) * 1024 + head * 256 + 64 * fq + 16 * (dt >> 2)) = ow1; } }
#else
            static_assert(FP8_O, "the memory V^T rows are stored permuted for the e4m3 output path");
            u32x2 w; w.x = pk2(o0[0], o0[1]); w.y = pk2(o0[2], o0[3]); *(u32x2*)(O + tokq * 1024 + head * 256 + 16 * dt + 4 * fq) = w;
            w.x = pk2(o1[0], o1[1]); w.y = pk2(o1[2], o1[3]); *(u32x2*)(O + (tokq + 16) * 1024 + head * 256 + 16 * dt + 4 * fq) = w; }
#endif
    }
}

__device__ __forceinline__ void router_phase(const Params& p, LAS unsigned char* lds, int layer) {
    LAUNDER_IDS();
    unsigned char* ws = p.ws;
    const int tid = TIDX, lane = tid & 63, wave = tid >> 6;
    LAS unsigned* hist = (LAS unsigned*)(lds + MISC_OFF + 2048); LAS unsigned* basev = hist + 32;
    const bf16_t* h = (const bf16_t*)(ws + WS_H);
    const bf16_t* whi = (const bf16_t*)(ws + WS_WRHI) + (size_t)layer * 32 * 1024; const bf16_t* wlo = (const bf16_t*)(ws + WS_WRLO) + (size_t)layer * 32 * 1024;
    const float* rb = p.in[24] + layer * 32;
    int* tslot = (int*)(ws + WS_TSLOT); float* gates = (float*)(ws + WS_GATE); int* list = (int*)(ws + WS_LIST);
    unsigned* cnt = (unsigned*)(ws + CTL_CNT) + layer * 32;
    const int hs = lane >> 5, tl = lane & 31;
    for (int chunk = BIDX; chunk < MT / 256; chunk += GDIMX) {
        __syncthreads();
        if (tid < 32) hist[tid] = 0u;
        __syncthreads();
        const size_t tok = (size_t)chunk * 256 + wave * 32 + tl;
        const bf16_t* hp = h + tok * 1024 + 8 * hs; const bf16_t* ap = whi + (size_t)tl * 1024 + 8 * hs; const bf16_t* lp = wlo + (size_t)tl * 1024 + 8 * hs;
        f32x16 acc;
#pragma unroll
        for (int i = 0; i < 16; ++i) acc[i] = 0.f;
#pragma unroll 8
        for (int kk = 0; kk < 64; ++kk) { const bf16x8 bq = *(const bf16x8*)(hp + 16 * kk); const bf16x8 a1 = *(const bf16x8*)(ap + 16 * kk), a2 = *(const bf16x8*)(lp + 16 * kk);
            acc = __builtin_amdgcn_mfma_f32_32x32x16_bf16(a1, bq, acc, 0, 0, 0); acc = __builtin_amdgcn_mfma_f32_32x32x16_bf16(a2, bq, acc, 0, 0, 0); }
        float v[16];
#pragma unroll
        for (int i = 0; i < 16; ++i) v[i] = acc[i] + rb[(i & 3) + 8 * (i >> 2) + 4 * hs];
        float sv[4]; int si[4];
#pragma unroll
        for (int s = 0; s < 4; ++s) { float best = -3.0e38f; int bi = 99;
#pragma unroll
            for (int i = 0; i < 16; ++i) { const int id = (i & 3) + 8 * (i >> 2) + 4 * hs; if (v[i] > best || (v[i] == best && id < bi)) { best = v[i]; bi = id; } }
            sv[s] = best; si[s] = bi;
#pragma unroll
            for (int i = 0; i < 16; ++i) { const int id = (i & 3) + 8 * (i >> 2) + 4 * hs; if (id == bi) v[i] = -3.0e38f; } }
        float cv[8]; int ci[8];
#pragma unroll
        for (int s = 0; s < 4; ++s) { cv[s] = sv[s]; ci[s] = si[s]; cv[4 + s] = __shfl_xor(sv[s], 32); ci[4 + s] = __shfl_xor(si[s], 32); }
        float tv_[4]; int ti[4];
#pragma unroll
        for (int s = 0; s < 4; ++s) { float best = -3.0e38f; int bi = 99;
#pragma unroll
            for (int i = 0; i < 8; ++i) if (cv[i] > best || (cv[i] == best && ci[i] < bi)) { best = cv[i]; bi = ci[i]; }
            tv_[s] = best; ti[s] = bi & 31;
#pragma unroll
            for (int i = 0; i < 8; ++i) if (ci[i] == bi) cv[i] = -3.0e38f; }
        unsigned rk[4] = {0u, 0u, 0u, 0u};
        if (hs == 0) {
#pragma unroll
            for (int s = 0; s < 4; ++s) rk[s] = atomicAdd((unsigned*)&hist[ti[s]], 1u);
        }
        __syncthreads();
        if (tid < 32) { const unsigned hv = hist[tid]; basev[tid] = hv ? __hip_atomic_fetch_add(cnt + tid, hv, __ATOMIC_RELAXED, __HIP_MEMORY_SCOPE_AGENT) : 0u; }
        __syncthreads();
        if (hs == 0) {
            const float e1 = __expf(tv_[1] - tv_[0]), e2 = __expf(tv_[2] - tv_[0]), e3 = __expf(tv_[3] - tv_[0]); const float inv = 1.0f / (1.0f + e1 + e2 + e3);
            int code[4];
#pragma unroll
            for (int s = 0; s < 4; ++s) { unsigned idx = basev[ti[s]] + rk[s]; idx = idx < 65536u ? idx : 65535u; list[(size_t)ti[s] * 65536 + idx] = (int)tok; code[s] = (ti[s] << 24) | (int)idx; }
            *(int4*)(tslot + tok * 4) = make_int4(code[0], code[1], code[2], code[3]);
            *(f32x4*)(gates + tok * 4) = (f32x4){inv, e1 * inv, e2 * inv, e3 * inv};
        }
    }
}
__device__ __forceinline__ void moe_tables(const Params& p, LAS unsigned char* lds, int layer) {
    LAUNDER_IDS();
    LAS int* mi = (LAS int*)(lds + MISC_OFF + 64); LAS unsigned char* te = lds + MISC_OFF + 512;
    unsigned* cnt = (unsigned*)(p.ws + CTL_CNT) + layer * 32;
    __syncthreads();
    if (TIDX < 64) { const int e = TIDX & 31; unsigned c = __hip_atomic_load(cnt + e, __ATOMIC_RELAXED, __HIP_MEMORY_SCOPE_AGENT); c = c < 65536u ? c : 65536u;
        const int tiles = (int)((c + 255u) >> 8); int incl = tiles;
#pragma unroll
        for (int o = 1; o < 32; o <<= 1) { const int t = __shfl_up(incl, o, 32); if (e >= o) incl += t; }
        const int base = incl - tiles;
        if (TIDX < 32) { mi[1 + e] = base; mi[40 + e] = (int)c; if (e == 31) mi[0] = incl < NT_MAX ? incl : NT_MAX;
            for (int t = 0; t < tiles && base + t < NT_MAX; ++t) te[base + t] = (unsigned char)e; } }
    __syncthreads();
}

template <class Epi, bool FP8 = false>
__device__ __forceinline__ void gemm_std(LAS unsigned char* lds, const bf16_t* A, const bf16_t* Bt, int M, int N, int K, const Epi& E, int c_shift) {
    LAUNDER_IDS();
    pg8::Gemm g{A, Bt, M, N, K}; pg8::StaticOrder S; S.init(M, N, GDIMX, (BIDX + c_shift) % GDIMX);
    pg8::gemm_phase<Epi, pg8::StaticOrder, true, true, FP8>(lds, g, S, E);
}
constexpr int N_PHASES = 2 + (2 + 2 + 7) + (2 + 2 + 7) + (1 + 2 + 7) + (2 + 2 + 7);
__device__ __forceinline__ void wg_seam() { asm volatile("s_waitcnt vmcnt(0)" ::: "memory"); __syncthreads(); __builtin_amdgcn_fence(__ATOMIC_ACQUIRE, "agent"); asm volatile("s_waitcnt vmcnt(0)" ::: "memory"); }

__device__ __forceinline__ void grid_barrier(const XcdBarrier& b0) {
    XcdBarrier b = b0; unsigned long long a = (unsigned long long)b.bar; unsigned x = b.x;
    asm volatile("" : "+s"(a), "+s"(x)); b.bar = (unsigned*)a; b.x = x;
    xcd_barrier(b);
}
__device__ __forceinline__ LAS unsigned char* l_lds(LAS unsigned char* p) { unsigned a = (unsigned)(unsigned long long)p; asm volatile("" : "+s"(a)); return (LAS unsigned char*)(unsigned long long)a; }
typedef const __attribute__((address_space(4))) Params* KParams;
__device__ __forceinline__ Params load_params() {
    unsigned long long a = (unsigned long long)__builtin_amdgcn_kernarg_segment_ptr();
    asm volatile("" : "+s"(a));
    KParams P = (KParams)a; Params p;
#pragma unroll
    for (int i = 0; i < 29; ++i) p.in[i] = P->in[i];
    p.pos = P->pos; p.out = P->out; p.ws = P->ws; p.lo = P->lo; p.hi = P->hi; p.li = P->li; p.pad = 0;
    return p;
}
#define PHASE_FN static __device__ __forceinline__ void
#define KARGS() const Params p = load_params(); unsigned char* const ws = p.ws; (void)ws
PHASE_FN f_prologue(LAS unsigned char* lds) { KARGS(); prologue_phase(p, lds); }
PHASE_FN f_memkv(LAS unsigned char* lds) { KARGS();
    gemm_std(lds, (const bf16_t*)(ws + WS_MEMB), (const bf16_t*)(ws + WS_WKV), 4096, 1024, 1024, EpiPlain{(bf16_t*)(ws + WS_KMEM), 1024, 4, nullptr, 0}, 0);
    gemm_std(lds, (const bf16_t*)(ws + WS_WKV) + (size_t)1024 * 1024, (const bf16_t*)(ws + WS_MEMB), 1024, 4096, 1024, EpiPlain{(bf16_t*)(ws + WS_VTMEM), 4096, 16, nullptr, 0}, 128); }
PHASE_FN f_hgrn_in(LAS unsigned char* lds, int j) { KARGS();
#if FP8_HGRN
    gemm_std<EpiHgrn, true>(lds, (const bf16_t*)(ws + WS_H8), (const bf16_t*)(ws + WS_WAIN8 + (size_t)j * 4096 * 1024), MT, 3072, 512,
             EpiHgrn{ws + WS_BIG, (const float*)(ws + WS_LB) + j * 1024, (float*)(ws + WS_HGS), 0x320, lds + ROWIDX_OFF}, 0);
    gemm_std(lds, (const bf16_t*)(ws + WS_H), (const bf16_t*)(ws + WS_WAIN) + ((size_t)j * 4096 + 1024) * 1024, MT, 1024, 1024,
             EpiHgrn{ws + WS_BIG, (const float*)(ws + WS_LB) + j * 1024, (float*)(ws + WS_HGS), 0x1, lds + ROWIDX_OFF}, 0); }
#elif FP8_HGRN_QI
    gemm_std<EpiHgrn, true>(lds, (const bf16_t*)(ws + WS_H8), (const bf16_t*)(ws + WS_WAIN8 + (size_t)j * 4096 * 1024), MT, 2048, 512,
             EpiHgrn{ws + WS_BIG, (const float*)(ws + WS_LB) + j * 1024, (float*)(ws + WS_HGS), 0x20, lds + ROWIDX_OFF}, 0);
    gemm_std(lds, (const bf16_t*)(ws + WS_H), (const bf16_t*)(ws + WS_WAIN) + ((size_t)j * 4096 + 1024) * 1024, MT, 1024, 1024,
             EpiHgrn{ws + WS_BIG, (const float*)(ws + WS_LB) + j * 1024, (float*)(ws + WS_HGS), 0x1, lds + ROWIDX_OFF}, 0);
    gemm_std(lds, (const bf16_t*)(ws + WS_H), (const bf16_t*)(ws + WS_WAIN) + ((size_t)j * 4096 + 3072) * 1024, MT, 1024, 1024,
             EpiHgrn{ws + WS_BIG, (const float*)(ws + WS_LB) + j * 1024, (float*)(ws + WS_HGS), 0x3, lds + ROWIDX_OFF}, 0); }
#elif FP8_HGRN_G
    gemm_std(lds, (const bf16_t*)(ws + WS_H), (const bf16_t*)(ws + WS_WAIN) + (size_t)j * 4096 * 1024, MT, 3072, 1024,
             EpiHgrn{ws + WS_BIG, (const float*)(ws + WS_LB) + j * 1024, (float*)(ws + WS_HGS), 0x210, lds + ROWIDX_OFF}, 0);
    gemm_std<EpiHgrn, true>(lds, (const bf16_t*)(ws + WS_H8), (const bf16_t*)(ws + WS_WAIN8 + ((size_t)j * 4096 + 2048) * 1024), MT, 1024, 512,
             EpiHgrn{ws + WS_BIG, (const float*)(ws + WS_LB) + j * 1024, (float*)(ws + WS_HGS), 0x3, lds + ROWIDX_OFF}, 0); }
#else
    gemm_std(lds, (const bf16_t*)(ws + WS_H), (const bf16_t*)(ws + WS_WAIN) + (size_t)j * 4096 * 1024, MT, 4096, 1024,
             EpiHgrn{ws + WS_BIG, (const float*)(ws + WS_LB) + j * 1024, (float*)(ws + WS_HGS), 0x3210, lds + ROWIDX_OFF}, 0); }
#endif
PHASE_FN f_hgrn_in_light(LAS unsigned char* lds, int j) { KARGS();
    gemm_std(lds, (const bf16_t*)(ws + WS_H), (const bf16_t*)(ws + WS_WAIN) + (size_t)j * 4096 * 1024, MT, 4096, 1024, EpiPlain{(bf16_t*)(ws + WS_BIG + 6 * ACT1), 4096, 16, nullptr, 0}, 0); }
PHASE_FN f_hgrn_scan(LAS unsigned char* lds, int j) { KARGS();
    hgrn_scan_phase(p, lds, j);
}
PHASE_FN f_dil_in(LAS unsigned char* lds) { KARGS();
#if FP8_DIL
    gemm_std<EpiRope, true>(lds, (const bf16_t*)(ws + WS_H8), (const bf16_t*)(ws + WS_WBIN), MT, 9216, 512, EpiRope{(bf16_t*)(ws + WS_BIG + BB_PROJ), p.pos, (const float*)(ws + WS_ROPE)}, 0); }
#else
    gemm_std(lds, (const bf16_t*)(ws + WS_H), (const bf16_t*)(ws + WS_WBIN), MT, 9216, 1024, EpiRope{(bf16_t*)(ws + WS_BIG + BB_PROJ), p.pos, (const float*)(ws + WS_ROPE)}, 0); }
#endif
PHASE_FN f_dil_attn(LAS unsigned char* lds) { KARGS(); dilated_attn_phase(p, lds); }
PHASE_FN f_s5(LAS unsigned char* lds) { KARGS(); s5_phase(p, lds); }
PHASE_FN f_gemm_plain(LAS unsigned char* lds, int which, int layer) { KARGS();
    const int kind = layer % 3, j = layer / 3;
    bf16_t* O = (bf16_t*)(ws + (which == 1 ? WS_T0 : WS_MIX));
    const bool f8 = which == 0 ? (FP8_MIXOUT || (FP8_DILOUT && kind == 1)) : (which == 1 ? FP8_Q : FP8_O);
    const size_t wb = f8 ? 1 : 2;
    const unsigned char* A = ws + (which == 0 ? WS_T0 : (which == 1 ? (FP8_Q ? WS_H8 : WS_H) : WS_T1));
    const unsigned char* Bt = which == 0 ? (kind == 0 ? ws + WS_WAOUT + (size_t)j * 1024 * 1024 * wb : ws + WS_WBOUT) : ws + (which == 1 ? WS_WQ : WS_WO) + (size_t)layer * 1024 * 1024 * wb;
    if (which == 1) {
        if (f8) gemm_std<EpiPlainT<true>, true>(lds, (const bf16_t*)A, (const bf16_t*)Bt, MT, 1024, 512, EpiPlainT<true>{O, 1024, 4, nullptr, 0}, 0);
        else gemm_std<EpiPlainT<true>, false>(lds, (const bf16_t*)A, (const bf16_t*)Bt, MT, 1024, 1024, EpiPlainT<true>{O, 1024, 4, nullptr, 0}, 0);
    } else if (FP8_MIX && (which == 2 || kind == 1)) {
        if (f8) gemm_std<EpiPlainT<true>, true>(lds, (const bf16_t*)A, (const bf16_t*)Bt, MT, 1024, 512, EpiPlainT<true>{O, 1024, 4, nullptr, 0}, 0);
        else gemm_std<EpiPlainT<true>, false>(lds, (const bf16_t*)A, (const bf16_t*)Bt, MT, 1024, 1024, EpiPlainT<true>{O, 1024, 4, nullptr, 0}, 0);
    } else if (f8) gemm_std<EpiPlain, true>(lds, (const bf16_t*)A, (const bf16_t*)Bt, MT, 1024, 512, EpiPlain{O, 1024, 4, nullptr, 0}, 0);
    else gemm_std<EpiPlain, false>(lds, (const bf16_t*)A, (const bf16_t*)Bt, MT, 1024, 1024, EpiPlain{O, 1024, 4, nullptr, 0}, 0); }
PHASE_FN f_s5_glu(LAS unsigned char* lds) { KARGS();
#if FP8_GLU
    gemm_std<EpiGlu<0, FP8_MIX != 0>, true>(lds, (const bf16_t*)(ws + WS_T0), (const bf16_t*)(ws + WS_WGLU), MT, 2048, 512, EpiGlu<0, FP8_MIX != 0>{(bf16_t*)(ws + WS_MIX), nullptr}, 0); }
#else
    gemm_std(lds, (const bf16_t*)(ws + WS_T0), (const bf16_t*)(ws + WS_WGLU), MT, 2048, 1024, EpiGlu<0>{(bf16_t*)(ws + WS_MIX), nullptr}, 0); }
#endif
PHASE_FN f_ln(LAS unsigned char* lds, int layer, int which, bool use_mix, bool dry = false) { KARGS(); ln_phase<0>(p, lds, layer, which, (const bf16_t*)(ws + WS_MIX), false, use_mix, (which == 1 || FP8_Q) && !dry ? ws + WS_H8 : nullptr, dry, FP8_MIX && (which == 1 || (layer % 3) != 0) && (FP8_GLU || (layer % 3) != 2), which == 1 && !dry); }
PHASE_FN f_cross(LAS unsigned char* lds) { KARGS(); cross_attn_phase(p, lds); }
PHASE_FN f_dbg(LAS unsigned char* lds) { KARGS(); dbg_scan_phase(p); }
PHASE_FN f_router(LAS unsigned char* lds, int layer) { KARGS(); router_phase(p, lds, layer); }
PHASE_FN f_moe_up(LAS unsigned char* lds, int layer) { KARGS(); moe_tables(p, lds, layer);
    LAS unsigned short* rowidx = (LAS unsigned short*)(lds + ROWIDX_OFF);
    MoeOrder S{l_gdim(), l_bid(), 8, ((LAS int*)(lds + MISC_OFF + 64))[0], (const LAS unsigned char*)(lds + MISC_OFF + 512), (const LAS int*)(lds + MISC_OFF + 64), (const int*)(ws + WS_LIST), 1024u, rowidx};
    { const int t = l_tid(), kh = t >> 8, r = t & 255;
      int tokv[17];
      pg8::Unit u0; S.next(0, u0);
#pragma unroll
      for (int j = 0; j < 17; ++j) { const int k = 2 * j + kh; pg8::Unit u; const bool ok = k < 33 && S.next(k, u); if (!ok) u = u0;
          int e, i0, cn; S.unit_rows(u, e, i0, cn); tokv[j] = S.row_tok(e, i0 + r, cn); }
#pragma unroll
      for (int j = 0; j < 17; ++j) { const int k = 2 * j + kh; if (k < 33) rowidx[k * 256 + r] = (unsigned short)tokv[j]; }
      __syncthreads(); }
    pg8::Gemm g{(const bf16_t*)(ws + WS_H8), (const bf16_t*)(ws + WS_W1 + (size_t)layer * 32 * 2048 * 1024), NSLOT, 32 * 2048, 512};
    pg8::gemm_phase_gather<EpiGlu<1, true>, MoeOrder, true, true, true>(lds, g, S, EpiGlu<1, true>{(bf16_t*)(ws + WS_BIG + BM_ACT), (const bf16_t*)(ws + WS_B1H) + (size_t)layer * 32 * 2048}); }
PHASE_FN f_moe_down(LAS unsigned char* lds, int layer) { KARGS(); if (p.hi - p.lo == 1) moe_tables(p, lds, layer);
    MoeOrder S{l_gdim(), l_bid(), 4, ((LAS int*)(lds + MISC_OFF + 64))[0], (const LAS unsigned char*)(lds + MISC_OFF + 512), (const LAS int*)(lds + MISC_OFF + 64), (const int*)(ws + WS_LIST), 1024u, nullptr};
    pg8::Gemm g{(const bf16_t*)(ws + WS_BIG + BM_ACT), (const bf16_t*)(ws + WS_W2 + (size_t)layer * 32 * 1024 * 1024), NSLOT, 32 * 1024, 512};
    pg8::gemm_phase<EpiPlainT<true>, MoeOrder, true, true, true>(lds, g, S, EpiPlainT<true>{(bf16_t*)(ws + WS_BIG + BM_YS), 1024, 4, nullptr, 0}); }
PHASE_FN f_ln_moe(LAS unsigned char* lds, int layer) { KARGS(); if (!DBG_NO_MOE && p.hi - p.lo == 1) moe_tables(p, lds, layer); ln_phase<1>(p, lds, layer, 2, (const bf16_t*)(ws + WS_BIG + BM_YS), layer == DEPTH - 1, true, ((FP8_DIL && layer == 0) || ((FP8_HGRN || FP8_HGRN_G || FP8_HGRN_QI) && layer == 2)) ? ws + WS_H8 : nullptr); }

__global__ void __launch_bounds__(512, 2) mk_fwd(Params p) {
    extern __shared__ __attribute__((aligned(16))) unsigned char lds_raw[];
    LAS unsigned char* lds0 = (LAS unsigned char*)lds_raw; LAS unsigned char* lds = l_lds(lds0);
    for (int u = l_tid(); u < (LDS_BYTES - MISC_OFF) / 4; u += 512) ((LAS unsigned*)(lds + MISC_OFF))[u] = 0u;
    __syncthreads();
    XcdBarrier bar = xcd_barrier_post((unsigned*)(p.ws + CTL_BAR) + (size_t)p.li * XCD_BAR_WORDS, (volatile LAS unsigned*)(lds + MISC_OFF));
    const int lo = p.lo, hi = p.hi; int ph = 0;
#define PH(call) do { if (ph >= lo && ph < hi) { LAS unsigned char* lds = l_lds(lds0); call; if (ph + 1 < hi) { grid_barrier(bar); if (DBG_REPEAT & (1 << 20)) grid_barrier(bar); } } ++ph; } while (0)
#ifndef DBG_REPEAT
#define DBG_REPEAT 0
#endif
#define PHR(bit, call) PH(call; if (DBG_REPEAT & (1 << (bit))) { call; })
    PHR(0, f_prologue(lds));
    PH(f_memkv(lds));
#define LAYER_BODY(layer) do { constexpr int kind = (layer) % 3, j = (layer) / 3; \
        if (kind == 0) { PH(f_hgrn_in(lds, j); if (DBG_REPEAT & 2) f_hgrn_in(lds, j); if (DBG_REPEAT & (1 << 21)) f_hgrn_in_light(lds, j)); PHR(2, f_hgrn_scan(lds, j)); } \
        else if (kind == 1) { PHR(3, f_dil_in(lds)); PHR(4, f_dil_attn(lds)); } \
        else { PHR(6, f_s5(lds)); } \
        if (kind != 2) PHR(7, f_gemm_plain(lds, 0, layer)); else PHR(8, f_s5_glu(lds)); \
        PH(f_ln(lds, layer, 0, true); if (DBG_REPEAT & (1 << 9)) f_ln(lds, layer, 0, true, true)); \
        PHR(7, f_gemm_plain(lds, 1, layer)); \
        PHR(10, f_cross(lds)); \
        PHR(7, f_gemm_plain(lds, 2, layer)); \
        PH(f_ln(lds, layer, 1, true); if (DBG_REPEAT & (1 << 9)) f_ln(lds, layer, 1, true, true); wg_seam(); f_router(lds, layer));   \
        PHR(13, f_moe_up(lds, layer)); \
        PHR(14, f_moe_down(lds, layer)); \
        PH(f_ln_moe(lds, layer)); } while (0)
    LAYER_BODY(0); LAYER_BODY(1); LAYER_BODY(2); LAYER_BODY(3);
#undef LAYER_BODY
#undef PH
}

#ifndef MK_SINGLE
#define MK_SINGLE 1
#endif
extern "C" void kernel_launch(void* const* d_in, const int* in_sizes, int n_in, void* d_out, int out_size, void* d_ws, size_t ws_size, hipStream_t stream) {
    static int grid = 0;
    if (grid == 0) {
        if (n_in != 29 || out_size != MT * DM || ws_size < WS_END) { fprintf(stderr, "kernel_launch: unexpected shapes (n_in %d, out %d, ws %zu < %zu)\n", n_in, out_size, ws_size, (size_t)WS_END); grid = -1; return; }
        int dev = 0, cus = 0, per_cu = 0;
        if (hipGetDevice(&dev) != hipSuccess || hipDeviceGetAttribute(&cus, hipDeviceAttributeMultiprocessorCount, dev) != hipSuccess) { grid = -1; return; }
        if (hipFuncSetAttribute((const void*)mk_fwd, hipFuncAttributeMaxDynamicSharedMemorySize, LDS_BYTES) != hipSuccess) { fprintf(stderr, "kernel_launch: hipFuncSetAttribute failed\n"); grid = -1; return; }
        if (hipOccupancyMaxActiveBlocksPerMultiprocessor(&per_cu, (const void*)mk_fwd, 512, LDS_BYTES) != hipSuccess || per_cu < 1) { fprintf(stderr, "kernel_launch: occupancy query says %d\n", per_cu); }
        (void)hipGetLastError();
        grid = cus;
    }
    if (grid < 0) return;
    (void)hipMemsetAsync((char*)d_ws + WS_CTL, 0, CTL_BYTES, stream);
    Params p{};
    for (int i = 0; i < 29; ++i) p.in[i] = (const float*)d_in[i];
    p.pos = (const int*)d_in[2]; p.out = (float*)d_out; p.ws = (unsigned char*)d_ws; p.pad = 0;
#if MK_SINGLE
    p.lo = 0; p.hi = N_PHASES; p.li = 0;
    hipLaunchKernelGGL(mk_fwd, dim3(grid), dim3(512), LDS_BYTES, stream, p);
#else
    for (int ph = 0; ph < N_PHASES; ++ph) { p.lo = ph; p.hi = ph + 1; p.li = 0; hipLaunchKernelGGL(mk_fwd, dim3(grid), dim3(512), LDS_BYTES, stream, p); }
#endif
    const hipError_t le = hipPeekAtLastError();
    if (le != hipSuccess) fprintf(stderr, "kernel_launch: launch failed: %s\n", hipGetErrorName(le));
}
```

```cpp
#include <hip/hip_runtime.h>
#include <cstdio>
#include <cstdint>
namespace pg8 {
#define PG8_LAS __attribute__((address_space(3)))
typedef unsigned short bf16_t;
typedef short bf16x8 __attribute__((ext_vector_type(8)));
typedef float f32x4 __attribute__((ext_vector_type(4)));
typedef int i32x4 __attribute__((ext_vector_type(4)));
typedef unsigned u32x4 __attribute__((ext_vector_type(4)));
constexpr int BM = 256, BK = 64, HALF = 128, HTB = HALF * BK * 2  , STAGE_BYTES = 8 * HTB, NXCD = 8, WGM = 8;

__host__ __device__ __forceinline__ int lds_byte(int r, int c) { const int st = (r >> 4) * 2 + (c >> 5), rr = r & 15, cc = c & 31, ob = rr * 64 + cc * 2; return st * 1024 + (ob ^ (((ob >> 9) & 1) << 5)); }
__host__ __device__ __forceinline__ void stage_rc(int b, int& R, int& C) { const int st = b / 1024, sb = b % 1024, swz = sb ^ (((sb >> 9) & 1) << 5); R = (st >> 1) * 16 + swz / 64; C = (st & 1) * 32 + (swz % 64) / 2; }
__host__ __device__ __forceinline__ int perm32(int rho) { const int n = rho >> 4, i = rho & 15; return 8 * (i >> 2) + 4 * n + (i & 3); }

struct Unit { int pm, pn; };
struct Gemm { const bf16_t* A; const bf16_t* Bt; int M, N, K; };

struct StaticOrder {
    int nM, nN, nwg, G, c;
    __host__ __device__ void init(int M, int N, int G_, int c_) { nM = M / BM; nN = N / BM; nwg = nM * nN; G = G_; c = c_; }
    __host__ __device__ bool next(int i, Unit& u) const {
        const long L = (long)i * G + c; if (L >= nwg) return false;
        int wgid = (int)L; { const int q = nwg / NXCD, r = nwg % NXCD, xcd = wgid % NXCD, off = wgid / NXCD; wgid = (xcd < r ? xcd * (q + 1) : r * (q + 1) + (xcd - r) * q) + off; }
        const int nig = WGM * nN, gid = wgid / nig, fm = gid * WGM, gsz = (nM - fm) < WGM ? (nM - fm) : WGM;
        u.pm = fm + ((wgid % nig) % gsz); u.pn = (wgid % nig) / gsz; return true;
    }
    __device__ __forceinline__ void a_ready(const Unit&) const {}
    __device__ __forceinline__ void done(const Unit&) const {}
};

typedef float cvt_f32x2 __attribute__((ext_vector_type(2)));
typedef __bf16 cvt_bf16x2 __attribute__((ext_vector_type(2)));
__device__ __forceinline__ unsigned cvt_pk_bf16(float lo, float hi) { const cvt_f32x2 v = {lo, hi}; const cvt_bf16x2 r = __builtin_convertvector(v, cvt_bf16x2); return __builtin_bit_cast(unsigned, r); }
template <class Epi, class Sched, bool ALIGN_EPI = false, bool SP2 = false, bool FP8 = false>
__device__ __forceinline__ void gemm_phase(PG8_LAS unsigned char* lds, const Gemm g, const Sched& S, const Epi& E) {
    int tid_ = threadIdx.x; asm volatile("" : "+v"(tid_)); const int tid = tid_, wid = __builtin_amdgcn_readfirstlane(tid >> 6), lane = tid & 63, wr = wid >> 2, wc = wid & 3, fr = lane & 15, fq = lane >> 4;
    const int K = g.K, nt = K / BK;
    unsigned voffA[2], voffB[2];
#pragma unroll
    for (int i = 0; i < 2; ++i) { int R, C; stage_rc(tid * 16 + i * 8192, R, C); const int Rb = Epi::PERM ? ((R & ~31) + perm32(R & 31)) : R;
        voffA[i] = (unsigned)(R * K + C) * 2u; voffB[i] = (unsigned)(Rb * K + C) * 2u; }
    const size_t kstep = (size_t)(BK * 2);
    const size_t hstep = (size_t)HALF * K * 2;
    const size_t tstep = 2 * hstep;
    const unsigned ldsw = (unsigned)wid * 1024u;
    const int aoff = lds_byte(wr * 64 + fr, fq * 8), boff = lds_byte(wc * 32 + fr, fq * 8);
#define PG8_SA(b, h) (((b) * 2 + (h)) * HTB)
#define PG8_SB(b, h) ((4 + (b) * 2 + (h)) * HTB)
#define PG8_STAGE(bufoff, gbase, voff) do { _Pragma("unroll") for (int _i = 0; _i < 2; ++_i) \
        __builtin_amdgcn_global_load_lds((const unsigned*)((const char*)(gbase) + (voff)[_i]), (PG8_LAS unsigned*)(lds + (bufoff) + ldsw + _i * 8192), 16, 0, 0); } while (0)
#define PG8_LDA(dst, b, h) do { _Pragma("unroll") for (int m = 0; m < 4; ++m) _Pragma("unroll") for (int k = 0; k < 2; ++k) dst[m][k] = *(const PG8_LAS bf16x8*)(lds + PG8_SA(b, h) + aoff + m * 2048 + k * 1024); } while (0)
#define PG8_LDB(dst, b, h) do { _Pragma("unroll") for (int n = 0; n < 2; ++n) _Pragma("unroll") for (int k = 0; k < 2; ++k) dst[n][k] = *(const PG8_LAS bf16x8*)(lds + PG8_SB(b, h) + boff + n * 2048 + k * 1024); } while (0)
#define PG8_MMA(ai, bj, At, Bt) do { __builtin_amdgcn_s_setprio(1); _Pragma("unroll") for (int m = 0; m < 4; ++m) _Pragma("unroll") for (int n = 0; n < 2; ++n) { \
        if constexpr (FP8) acc[ai][bj][m][n] = __builtin_amdgcn_mfma_scale_f32_16x16x128_f8f6f4( \
            __builtin_shufflevector(__builtin_bit_cast(i32x4, Bt[n][0]), __builtin_bit_cast(i32x4, Bt[n][1]), 0, 1, 2, 3, 4, 5, 6, 7), \
            __builtin_shufflevector(__builtin_bit_cast(i32x4, At[m][0]), __builtin_bit_cast(i32x4, At[m][1]), 0, 1, 2, 3, 4, 5, 6, 7), acc[ai][bj][m][n], 0, 0, 0, 121, 0, 127); \
        else { _Pragma("unroll") for (int k = 0; k < 2; ++k) acc[ai][bj][m][n] = __builtin_amdgcn_mfma_f32_16x16x32_bf16(Bt[n][k], At[m][k], acc[ai][bj][m][n], 0, 0, 0); } } \
        if constexpr (FP8) { _Pragma("unroll") for (int m = 0; m < 4; ++m) _Pragma("unroll") for (int n = 0; n < 2; ++n) asm volatile("" : "+v"(acc[ai][bj][m][n]) :: "memory"); }     \
        __builtin_amdgcn_s_setprio(0); } while (0)
#define PG8_WAIT_V(n) asm volatile("s_waitcnt vmcnt(" #n ")" ::: "memory")
#define PG8_WAIT_L(n) asm volatile("s_waitcnt lgkmcnt(" #n ")" ::: "memory")
#define PG8_BAR __builtin_amdgcn_s_barrier()
#define PG8_SCHED __builtin_amdgcn_sched_barrier(0)
    Unit cur, nxt; int ui = 0;
    if (!S.next(0, cur)) return;
    f32x4 acc[2][2][4][2];
#pragma unroll
    for (int a = 0; a < 2; ++a)
#pragma unroll
        for (int b = 0; b < 2; ++b)
#pragma unroll
            for (int m = 0; m < 4; ++m)
#pragma unroll
                for (int n = 0; n < 2; ++n) acc[a][b][m][n] = (f32x4){0.f, 0.f, 0.f, 0.f};
    bf16x8 At[4][2], B0[2][2], B1[2][2];
    const char* cA = (const char*)g.A + (size_t)cur.pm * tstep; const char* cB = (const char*)g.Bt + (size_t)cur.pn * tstep;
    S.a_ready(cur);
    if constexpr (SP2) {
        PG8_STAGE(PG8_SB(0, 0), cB, voffB); PG8_STAGE(PG8_SB(0, 1), cB + hstep, voffB); PG8_STAGE(PG8_SA(0, 0), cA, voffA); PG8_STAGE(PG8_SA(0, 1), cA + hstep, voffA);
        if (wr == 1) PG8_BAR;
        PG8_WAIT_V(2); PG8_BAR;
        PG8_STAGE(PG8_SB(1, 0), cB + kstep, voffB); PG8_STAGE(PG8_SA(1, 0), cA + kstep, voffA); PG8_STAGE(PG8_SB(1, 1), cB + hstep + kstep, voffB);
        PG8_WAIT_V(6); PG8_BAR;
    } else {
        PG8_STAGE(PG8_SB(0, 0), cB, voffB); PG8_STAGE(PG8_SA(0, 0), cA, voffA); PG8_STAGE(PG8_SB(0, 1), cB + hstep, voffB); PG8_STAGE(PG8_SA(0, 1), cA + hstep, voffA);
        if (wr == 1) PG8_BAR;
        PG8_WAIT_V(4); PG8_BAR;
        PG8_STAGE(PG8_SB(1, 0), cB + kstep, voffB); PG8_STAGE(PG8_SA(1, 0), cA + kstep, voffA); PG8_STAGE(PG8_SB(1, 1), cB + hstep + kstep, voffB);
        PG8_WAIT_V(6); PG8_BAR;
    }
    for (;;) {
        const bool has_next = S.next(ui + 1, nxt);
        const char* nA = has_next ? (const char*)g.A + (size_t)nxt.pm * tstep : cA; const char* nB = has_next ? (const char*)g.Bt + (size_t)nxt.pn * tstep : cB;
        for (int t = 0; t < nt; t += 2) {
            const bool last = (t == nt - 2);
            const char* a1 = cA + (size_t)(t + 1) * kstep;
            const char* a2 = last ? nA : cA + (size_t)(t + 2) * kstep; const char* b2 = last ? nB : cB + (size_t)(t + 2) * kstep;
            const char* a3 = a2 + kstep; const char* b3 = b2 + kstep;
            if (last && has_next) S.a_ready(nxt);
            if constexpr (SP2) {
            PG8_LDB(B0, 0, 0); PG8_LDB(B1, 0, 1); PG8_SCHED; PG8_LDA(At, 0, 0); PG8_STAGE(PG8_SA(1, 1), a1 + hstep, voffA);
            PG8_WAIT_V(8); PG8_WAIT_L(0); PG8_BAR; PG8_MMA(0, 0, At, B0); PG8_MMA(0, 1, At, B1); PG8_BAR; PG8_SCHED;
            PG8_LDA(At, 0, 1); PG8_STAGE(PG8_SB(0, 0), b2, voffB); PG8_STAGE(PG8_SB(0, 1), b2 + hstep, voffB); PG8_STAGE(PG8_SA(0, 0), a2, voffA);
            PG8_WAIT_V(8); PG8_WAIT_L(0); PG8_BAR; PG8_MMA(1, 0, At, B0); PG8_MMA(1, 1, At, B1); PG8_BAR; PG8_SCHED;
            PG8_LDB(B0, 1, 0); PG8_LDB(B1, 1, 1); PG8_SCHED; PG8_LDA(At, 1, 0); PG8_STAGE(PG8_SA(0, 1), a2 + hstep, voffA);
            PG8_WAIT_V(8); PG8_WAIT_L(0); PG8_BAR; PG8_MMA(0, 0, At, B0); PG8_MMA(0, 1, At, B1); PG8_BAR; PG8_SCHED;
            PG8_LDA(At, 1, 1); PG8_STAGE(PG8_SB(1, 0), b3, voffB); PG8_STAGE(PG8_SB(1, 1), b3 + hstep, voffB); PG8_STAGE(PG8_SA(1, 0), a3, voffA);
            PG8_WAIT_V(8); PG8_WAIT_L(0); PG8_BAR; PG8_MMA(1, 0, At, B0); PG8_MMA(1, 1, At, B1); PG8_BAR; PG8_SCHED;
            } else {
            PG8_LDB(B0, 0, 0); PG8_SCHED; PG8_LDA(At, 0, 0); PG8_STAGE(PG8_SA(1, 1), a1 + hstep, voffA);
            PG8_WAIT_L(8); PG8_BAR; PG8_WAIT_L(0); PG8_MMA(0, 0, At, B0); PG8_BAR; PG8_SCHED;
            PG8_LDB(B1, 0, 1); PG8_STAGE(PG8_SB(0, 0), b2, voffB);
            PG8_BAR; PG8_WAIT_L(0); PG8_MMA(0, 1, At, B1); PG8_BAR;
            PG8_LDA(At, 0, 1); PG8_STAGE(PG8_SA(0, 0), a2, voffA);
            PG8_BAR; PG8_WAIT_L(0); PG8_MMA(1, 0, At, B0); PG8_BAR; PG8_SCHED;
            PG8_STAGE(PG8_SB(0, 1), b2 + hstep, voffB);
            PG8_WAIT_V(6); PG8_BAR; PG8_MMA(1, 1, At, B1); PG8_BAR;
            PG8_LDB(B0, 1, 0); PG8_SCHED; PG8_LDA(At, 1, 0); PG8_STAGE(PG8_SA(0, 1), a2 + hstep, voffA);
            PG8_WAIT_L(8); PG8_BAR; PG8_WAIT_L(0); PG8_MMA(0, 0, At, B0); PG8_BAR; PG8_SCHED;
            PG8_LDB(B1, 1, 1); PG8_STAGE(PG8_SB(1, 0), b3, voffB);
            PG8_BAR; PG8_WAIT_L(0); PG8_MMA(0, 1, At, B1); PG8_BAR;
            PG8_LDA(At, 1, 1); PG8_STAGE(PG8_SA(1, 0), a3, voffA);
            PG8_BAR; PG8_WAIT_L(0); PG8_MMA(1, 0, At, B0); PG8_BAR; PG8_SCHED;
            PG8_STAGE(PG8_SB(1, 1), b3 + hstep, voffB);
            PG8_WAIT_V(6); PG8_BAR; PG8_MMA(1, 1, At, B1); PG8_BAR;
            }
        }
        if constexpr (ALIGN_EPI) { if (wr == 0) PG8_BAR; }
        if constexpr (!Epi::AFTER_DRAIN) { E(acc, cur, wr, wc, fr, fq); S.done(cur); }
        if (!has_next) break;
#pragma unroll
        for (int a = 0; a < 2; ++a)
#pragma unroll
            for (int b = 0; b < 2; ++b)
#pragma unroll
                for (int m = 0; m < 4; ++m)
#pragma unroll
                    for (int n = 0; n < 2; ++n) acc[a][b][m][n] = (f32x4){0.f, 0.f, 0.f, 0.f};
        cur = nxt; cA = nA; cB = nB; ++ui;
        if constexpr (ALIGN_EPI) { if (wr == 1) PG8_BAR; }
    }
    PG8_WAIT_V(0);
    if constexpr (!ALIGN_EPI) { if (wr == 0) PG8_BAR; }
    PG8_BAR;
    if constexpr (Epi::AFTER_DRAIN) { E.fused(acc, cur, wr, wc, fr, fq, lds, wid, lane); S.done(cur); }
#undef PG8_SA
#undef PG8_SB
#undef PG8_STAGE
#undef PG8_LDA
#undef PG8_LDB
#undef PG8_MMA
#undef PG8_WAIT_V
#undef PG8_WAIT_L
#undef PG8_BAR
#undef PG8_SCHED
}

template <class Epi, class Sched, bool ALIGN_EPI = true, bool SP2 = true, bool FP8 = false>
__device__ __forceinline__ void gemm_phase_gather(PG8_LAS unsigned char* lds, const Gemm g, const Sched& S, const Epi& E) {
    int tid_ = threadIdx.x; asm volatile("" : "+v"(tid_)); const int tid = tid_, wid = __builtin_amdgcn_readfirstlane(tid >> 6), lane = tid & 63, wr = wid >> 2, wc = wid & 3, fr = lane & 15, fq = lane >> 4;
    const int K = g.K, nt = K / BK;
    unsigned voffA[2], voffB[2]; int rA[2];
#pragma unroll
    for (int i = 0; i < 2; ++i) { int R, C; stage_rc(tid * 16 + i * 8192, R, C); const int Rb = Epi::PERM ? ((R & ~31) + perm32(R & 31)) : R;
        voffA[i] = (unsigned)C * 2u; voffB[i] = (unsigned)(Rb * K + C) * 2u; rA[i] = R; }
    const size_t kstep = (size_t)(BK * 2);
    const size_t hstep = (size_t)HALF * K * 2;
    const size_t tstep = 2 * hstep;
    const unsigned ldsw = (unsigned)wid * 1024u;
    const int aoff = lds_byte(wr * 64 + fr, fq * 8), boff = lds_byte(wc * 32 + fr, fq * 8);
#define PG8_SA(b, h) (((b) * 2 + (h)) * HTB)
#define PG8_SB(b, h) ((4 + (b) * 2 + (h)) * HTB)
#define PG8_STAGE(bufoff, gbase, voff) do { _Pragma("unroll") for (int _i = 0; _i < 2; ++_i) \
        __builtin_amdgcn_global_load_lds((const unsigned*)((const char*)(gbase) + (voff)[_i]), (PG8_LAS unsigned*)(lds + (bufoff) + ldsw + _i * 8192), 16, 0, 0); } while (0)
#define PG8_STAGE_A(b, h, kptr, offs) do { _Pragma("unroll") for (int _i = 0; _i < 2; ++_i) \
        __builtin_amdgcn_global_load_lds((const unsigned*)((const char*)(kptr) + (offs)[h][_i]), (PG8_LAS unsigned*)(lds + PG8_SA(b, h) + ldsw + _i * 8192), 16, 0, 0); } while (0)
#define PG8_GOFFS(dst, k_) do { _Pragma("unroll") for (int h_ = 0; h_ < 2; ++h_) _Pragma("unroll") for (int _i = 0; _i < 2; ++_i) \
        dst[h_][_i] = (unsigned)S.rowidx[(k_) * 256 + h_ * HALF + rA[_i]] * S.rowpitch + voffA[_i]; } while (0)
#define PG8_LDA(dst, b, h) do { _Pragma("unroll") for (int m = 0; m < 4; ++m) _Pragma("unroll") for (int k = 0; k < 2; ++k) dst[m][k] = *(const PG8_LAS bf16x8*)(lds + PG8_SA(b, h) + aoff + m * 2048 + k * 1024); } while (0)
#define PG8_LDB(dst, b, h) do { _Pragma("unroll") for (int n = 0; n < 2; ++n) _Pragma("unroll") for (int k = 0; k < 2; ++k) dst[n][k] = *(const PG8_LAS bf16x8*)(lds + PG8_SB(b, h) + boff + n * 2048 + k * 1024); } while (0)
#define PG8_MMA(ai, bj, At, Bt) do { __builtin_amdgcn_s_setprio(1); _Pragma("unroll") for (int m = 0; m < 4; ++m) _Pragma("unroll") for (int n = 0; n < 2; ++n) { \
        if constexpr (FP8) acc[ai][bj][m][n] = __builtin_amdgcn_mfma_scale_f32_16x16x128_f8f6f4( \
            __builtin_shufflevector(__builtin_bit_cast(i32x4, Bt[n][0]), __builtin_bit_cast(i32x4, Bt[n][1]), 0, 1, 2, 3, 4, 5, 6, 7), \
            __builtin_shufflevector(__builtin_bit_cast(i32x4, At[m][0]), __builtin_bit_cast(i32x4, At[m][1]), 0, 1, 2, 3, 4, 5, 6, 7), acc[ai][bj][m][n], 0, 0, 0, 121, 0, 127); \
        else { _Pragma("unroll") for (int k = 0; k < 2; ++k) acc[ai][bj][m][n] = __builtin_amdgcn_mfma_f32_16x16x32_bf16(Bt[n][k], At[m][k], acc[ai][bj][m][n], 0, 0, 0); } } \
        if constexpr (FP8) { _Pragma("unroll") for (int m = 0; m < 4; ++m) _Pragma("unroll") for (int n = 0; n < 2; ++n) asm volatile("" : "+v"(acc[ai][bj][m][n]) :: "memory"); }     \
        __builtin_amdgcn_s_setprio(0); } while (0)
#define PG8_WAIT_V(n) asm volatile("s_waitcnt vmcnt(" #n ")" ::: "memory")
#define PG8_WAIT_L(n) asm volatile("s_waitcnt lgkmcnt(" #n ")" ::: "memory")
#define PG8_BAR __builtin_amdgcn_s_barrier()
#define PG8_SCHED __builtin_amdgcn_sched_barrier(0)
    Unit cur, nxt; int ui = 0;
    if (!S.next(0, cur)) return;
    f32x4 acc[2][2][4][2];
#pragma unroll
    for (int a = 0; a < 2; ++a)
#pragma unroll
        for (int b = 0; b < 2; ++b)
#pragma unroll
            for (int m = 0; m < 4; ++m)
#pragma unroll
                for (int n = 0; n < 2; ++n) acc[a][b][m][n] = (f32x4){0.f, 0.f, 0.f, 0.f};
    bf16x8 At[4][2], B0[2][2], B1[2][2];
    const char* cA = (const char*)g.A; unsigned gA[2][2], gN[2][2]; PG8_GOFFS(gA, 0);
    typename Epi::State est; E.pre(cur, wc, fq, est);
    const char* cB = (const char*)g.Bt + (size_t)cur.pn * tstep;
    S.a_ready(cur);
    if constexpr (SP2) {
        PG8_STAGE(PG8_SB(0, 0), cB, voffB); PG8_STAGE(PG8_SB(0, 1), cB + hstep, voffB); PG8_STAGE_A(0, 0, cA, gA); PG8_STAGE_A(0, 1, cA, gA);
        if (wr == 1) PG8_BAR;
        PG8_WAIT_V(2); PG8_BAR;
        PG8_STAGE(PG8_SB(1, 0), cB + kstep, voffB); PG8_STAGE_A(1, 0, cA + kstep, gA); PG8_STAGE(PG8_SB(1, 1), cB + hstep + kstep, voffB);
        PG8_WAIT_V(6); PG8_BAR;
    } else {
        PG8_STAGE(PG8_SB(0, 0), cB, voffB); PG8_STAGE_A(0, 0, cA, gA); PG8_STAGE(PG8_SB(0, 1), cB + hstep, voffB); PG8_STAGE_A(0, 1, cA, gA);
        if (wr == 1) PG8_BAR;
        PG8_WAIT_V(4); PG8_BAR;
        PG8_STAGE(PG8_SB(1, 0), cB + kstep, voffB); PG8_STAGE_A(1, 0, cA + kstep, gA); PG8_STAGE(PG8_SB(1, 1), cB + hstep + kstep, voffB);
        PG8_WAIT_V(6); PG8_BAR;
    }
    for (;;) {
        const bool has_next = S.next(ui + 1, nxt);
        const char* nA = (const char*)g.A; if (has_next) PG8_GOFFS(gN, ui + 1); else { _Pragma("unroll") for (int h_ = 0; h_ < 2; ++h_) _Pragma("unroll") for (int _i = 0; _i < 2; ++_i) gN[h_][_i] = gA[h_][_i]; }
        const char* nB = has_next ? (const char*)g.Bt + (size_t)nxt.pn * tstep : cB;
        for (int t = 0; t < nt; t += 2) {
            const bool last = (t == nt - 2);
            const char* a1 = cA + (size_t)(t + 1) * kstep;
            const char* a2 = last ? nA : cA + (size_t)(t + 2) * kstep; const char* b2 = last ? nB : cB + (size_t)(t + 2) * kstep;
            const char* a3 = a2 + kstep; const char* b3 = b2 + kstep;
            unsigned g2[2][2]; _Pragma("unroll") for (int h_ = 0; h_ < 2; ++h_) _Pragma("unroll") for (int _i = 0; _i < 2; ++_i) g2[h_][_i] = last ? gN[h_][_i] : gA[h_][_i];
            if (last && has_next) S.a_ready(nxt);
            if constexpr (SP2) {
            PG8_LDB(B0, 0, 0); PG8_LDB(B1, 0, 1); PG8_SCHED; PG8_LDA(At, 0, 0); PG8_STAGE_A(1, 1, a1, gA);
            PG8_WAIT_V(8); PG8_WAIT_L(0); PG8_BAR; PG8_MMA(0, 0, At, B0); PG8_MMA(0, 1, At, B1); PG8_BAR; PG8_SCHED;
            PG8_LDA(At, 0, 1); PG8_STAGE(PG8_SB(0, 0), b2, voffB); PG8_STAGE(PG8_SB(0, 1), b2 + hstep, voffB); PG8_STAGE_A(0, 0, a2, g2);
            PG8_WAIT_V(8); PG8_WAIT_L(0); PG8_BAR; PG8_MMA(1, 0, At, B0); PG8_MMA(1, 1, At, B1); PG8_BAR; PG8_SCHED;
            PG8_LDB(B0, 1, 0); PG8_LDB(B1, 1, 1); PG8_SCHED; PG8_LDA(At, 1, 0); PG8_STAGE_A(0, 1, a2, g2);
            PG8_WAIT_V(8); PG8_WAIT_L(0); PG8_BAR; PG8_MMA(0, 0, At, B0); PG8_MMA(0, 1, At, B1); PG8_BAR; PG8_SCHED;
            PG8_LDA(At, 1, 1); PG8_STAGE(PG8_SB(1, 0), b3, voffB); PG8_STAGE(PG8_SB(1, 1), b3 + hstep, voffB); PG8_STAGE_A(1, 0, a3, g2);
            PG8_WAIT_V(8); PG8_WAIT_L(0); PG8_BAR; PG8_MMA(1, 0, At, B0); PG8_MMA(1, 1, At, B1); PG8_BAR; PG8_SCHED;
            } else {
            PG8_LDB(B0, 0, 0); PG8_SCHED; PG8_LDA(At, 0, 0); PG8_STAGE_A(1, 1, a1, gA);
            PG8_WAIT_L(8); PG8_BAR; PG8_WAIT_L(0); PG8_MMA(0, 0, At, B0); PG8_BAR; PG8_SCHED;
            PG8_LDB(B1, 0, 1); PG8_STAGE(PG8_SB(0, 0), b2, voffB);
            PG8_BAR; PG8_WAIT_L(0); PG8_MMA(0, 1, At, B1); PG8_BAR;
            PG8_LDA(At, 0, 1); PG8_STAGE_A(0, 0, a2, g2);
            PG8_BAR; PG8_WAIT_L(0); PG8_MMA(1, 0, At, B0); PG8_BAR; PG8_SCHED;
            PG8_STAGE(PG8_SB(0, 1), b2 + hstep, voffB);
            PG8_WAIT_V(6); PG8_BAR; PG8_MMA(1, 1, At, B1); PG8_BAR;
            PG8_LDB(B0, 1, 0); PG8_SCHED; PG8_LDA(At, 1, 0); PG8_STAGE_A(0, 1, a2, g2);
            PG8_WAIT_L(8); PG8_BAR; PG8_WAIT_L(0); PG8_MMA(0, 0, At, B0); PG8_BAR; PG8_SCHED;
            PG8_LDB(B1, 1, 1); PG8_STAGE(PG8_SB(1, 0), b3, voffB);
            PG8_BAR; PG8_WAIT_L(0); PG8_MMA(0, 1, At, B1); PG8_BAR;
            PG8_LDA(At, 1, 1); PG8_STAGE_A(1, 0, a3, g2);
            PG8_BAR; PG8_WAIT_L(0); PG8_MMA(1, 0, At, B0); PG8_BAR; PG8_SCHED;
            PG8_STAGE(PG8_SB(1, 1), b3 + hstep, voffB);
            PG8_WAIT_V(6); PG8_BAR; PG8_MMA(1, 1, At, B1); PG8_BAR;
            }
        }
        if constexpr (ALIGN_EPI) { if (wr == 0) PG8_BAR; }
        if constexpr (!Epi::AFTER_DRAIN) { E(acc, cur, wr, wc, fr, fq, est); S.done(cur); }
        if (!has_next) break;
#pragma unroll
        for (int a = 0; a < 2; ++a)
#pragma unroll
            for (int b = 0; b < 2; ++b)
#pragma unroll
                for (int m = 0; m < 4; ++m)
#pragma unroll
                    for (int n = 0; n < 2; ++n) acc[a][b][m][n] = (f32x4){0.f, 0.f, 0.f, 0.f};
        cur = nxt; cA = nA; cB = nB; ++ui; _Pragma("unroll") for (int h_ = 0; h_ < 2; ++h_) _Pragma("unroll") for (int _i = 0; _i < 2; ++_i) gA[h_][_i] = gN[h_][_i]; E.pre(cur, wc, fq, est);
        if constexpr (ALIGN_EPI) { if (wr == 1) PG8_BAR; }
    }
    PG8_WAIT_V(0);
    if constexpr (!ALIGN_EPI) { if (wr == 0) PG8_BAR; }
    PG8_BAR;
    if constexpr (Epi::AFTER_DRAIN) { E.fused(acc, cur, wr, wc, fr, fq, lds, wid, lane); S.done(cur); }
#undef PG8_SA
#undef PG8_SB
#undef PG8_STAGE
#undef PG8_STAGE_A
#undef PG8_GOFFS
#undef PG8_LDA
#undef PG8_LDB
#undef PG8_MMA
#undef PG8_WAIT_V
#undef PG8_WAIT_L
#undef PG8_BAR
#undef PG8_SCHED
}
}
#define XB_TMO      128
#define XB_XCNT(j)  (256  + 64 * (j))
#define XB_XSUB(j)  (1280 + 64 * (j))
#define XB_XGEN(j)  (2304 + 64 * (j))
#define XB_TOP      3328
#define XB_TOPGEN   3392
#define XCD_BAR_WORDS 3456
#define XB_SPIN_CAP (1u << 22)
#define LAS __attribute__((address_space(3)))

__device__ __forceinline__ unsigned xb_ld(unsigned* p)              { return __hip_atomic_load(p, __ATOMIC_RELAXED, __HIP_MEMORY_SCOPE_AGENT); }
__device__ __forceinline__ unsigned xb_add(unsigned* p, unsigned v) { return __hip_atomic_fetch_add(p, v, __ATOMIC_RELAXED, __HIP_MEMORY_SCOPE_AGENT); }
__device__ __forceinline__ unsigned xb_xcc_id() { return (unsigned)__builtin_amdgcn_s_getreg((3 << 11) | 20) & 0xFu; }
#define XB_SPIN(cond, bar) do { unsigned _sp = 0; while (cond) { __builtin_amdgcn_s_sleep(1); \
    if ((++_sp & 255u) == 0u) { if (xb_ld(&(bar)[XB_TMO])) break; if (_sp > XB_SPIN_CAP) { atomicAdd(&(bar)[XB_TMO], 1u); break; } } } } while (0)

struct XcdBarrier {
    unsigned* bar; unsigned x;
    volatile LAS unsigned* st;
};

__device__ __forceinline__ XcdBarrier xcd_barrier_post(unsigned* bar, volatile LAS unsigned* st) {
    XcdBarrier b; b.bar = bar; b.x = xb_xcc_id(); b.st = st;
    if (threadIdx.x == 0) (void)xb_add(&bar[XB_XCNT(b.x)], 1u);
    return b;
}
__device__ __forceinline__ void xcd_barrier_complete(unsigned* bar, unsigned x, unsigned& nloc, unsigned& nx) {
    const unsigned G = gridDim.x * gridDim.y * gridDim.z;
    unsigned sum, cnt, mine, sp = 0u;
    for (;;) {
        sum = 0u; cnt = 0u; mine = 0u;
#pragma unroll
        for (unsigned j = 0; j < 16; ++j) { const unsigned c = xb_ld(&bar[XB_XCNT(j)]); sum += c; cnt += (c > 0u) ? 1u : 0u; mine = (j == x) ? c : mine; }
        if (sum == G) break;
        __builtin_amdgcn_s_sleep(1);
        if ((++sp & 255u) == 0u) { if (xb_ld(&bar[XB_TMO])) break; if (sp > XB_SPIN_CAP) { atomicAdd(&bar[XB_TMO], 1u); break; } }
    }
    nloc = mine > 0u ? mine : 1u; nx = cnt > 0u ? cnt : 1u;
}

__device__ __forceinline__ bool l_tid0() { int t = threadIdx.x; asm volatile("" : "+v"(t)); return t == 0; }
__device__ __forceinline__ void xcd_barrier(const XcdBarrier& b) {
    asm volatile("s_waitcnt vmcnt(0)" ::: "memory");
    __syncthreads();
    if (l_tid0()) {
        unsigned* bar = b.bar;
        __builtin_amdgcn_s_waitcnt(0);
        unsigned nloc = b.st[0], nx = b.st[1];
        if (nloc == 0u) { xcd_barrier_complete(bar, b.x, nloc, nx); b.st[0] = nloc; b.st[1] = nx; }
        const unsigned old = xb_add(&bar[XB_XSUB(b.x)], 1u);
        const unsigned gen = old / nloc;
        if (old + 1u == (gen + 1u) * nloc) {
            __builtin_amdgcn_fence(__ATOMIC_RELEASE, "agent");
            asm volatile("s_waitcnt vmcnt(0)" ::: "memory");
            const unsigned og = xb_add(&bar[XB_TOP], 1u);
            const unsigned tg = og / nx;
            if (og + 1u == (tg + 1u) * nx) xb_add(&bar[XB_TOPGEN], 1u);
            else XB_SPIN(xb_ld(&bar[XB_TOPGEN]) == tg, bar);
            __builtin_amdgcn_fence(__ATOMIC_ACQUIRE, "agent");
            xb_add(&bar[XB_XGEN(b.x)], 1u);
            asm volatile("s_waitcnt vmcnt(0)" ::: "memory");
        } else {
            XB_SPIN(xb_ld(&bar[XB_XGEN(b.x)]) == gen, bar);
            __builtin_amdgcn_fence(__ATOMIC_ACQUIRE, "agent");
            asm volatile("s_waitcnt vmcnt(0)" ::: "memory");
        }
    }
    __syncthreads();
}

typedef unsigned short bf16_t;
typedef short bf16x8 __attribute__((ext_vector_type(8)));
typedef short bf16x4 __attribute__((ext_vector_type(4)));
typedef float f32x4 __attribute__((ext_vector_type(4)));
typedef float f32x2 __attribute__((ext_vector_type(2)));
typedef float f32x16 __attribute__((ext_vector_type(16)));
typedef unsigned u32x4 __attribute__((ext_vector_type(4)));
typedef unsigned u32x2 __attribute__((ext_vector_type(2)));

constexpr int DM = 1024, NB = 16, SEQ = 4096, MT = NB * SEQ, MEML = 256, DEPTH = 4, NEXP = 32;
constexpr int NT_MAX = 1024 + 32;
constexpr int NSLOT = NT_MAX * 256;
constexpr float ALPHA = 1.681792830507429f;
constexpr float LN_EPS = 1e-5f;
constexpr int ROPE_POS = 5120;

constexpr int LDS_STAGE = 131072, MISC_OFF = 135168, ROWIDX_OFF = MISC_OFF + 8192, LDS_BYTES = ROWIDX_OFF + 33 * 512;

constexpr size_t AL(size_t x) { return (x + 255) & ~(size_t)255; }
constexpr size_t WS_CTL = 0;
constexpr size_t CTL_BAR = 0;
constexpr size_t CTL_CNT = 1u << 20;
constexpr size_t CTL_BYTES = (1u << 20) + 4096;
constexpr size_t WS_LB = 2u << 20;
constexpr size_t WS_S5LAM = WS_LB + AL(2 * 1024 * 4);
constexpr size_t WS_S5BB = WS_S5LAM + AL(64 * 64 * 2 * 4);
constexpr size_t WS_S5C = WS_S5BB + AL(64 * 64 * 32 * 4);
constexpr size_t WS_S5BT = WS_S5C + AL(64 * 16 * 128 * 2);
constexpr size_t WS_ROPE = WS_S5BT + AL(64 * 128 * 16 * 2);
constexpr size_t WS_WRHI = WS_ROPE + AL((size_t)ROPE_POS * 32 * 2 * 4);
constexpr size_t WS_WRLO = WS_WRHI + AL(4 * 32 * 1024 * 2);
constexpr size_t WS_B1H = WS_WRLO + AL(4 * 32 * 1024 * 2);
constexpr size_t WS_B2H = WS_B1H + AL(4 * 32 * 2048 * 2);
constexpr size_t WS_TOPI = WS_B2H + AL(4 * 32 * 1024 * 2);
constexpr size_t WS_GATE = WS_TOPI + AL((size_t)MT * 4 * 4);
constexpr size_t WS_TSLOT = WS_GATE + AL((size_t)MT * 4 * 4);
constexpr size_t WS_LIST = WS_TSLOT + AL((size_t)MT * 4 * 4);
constexpr size_t WS_LSE = WS_LIST + AL((size_t)32 * 65536 * 4);
constexpr size_t WS_HGS = WS_LSE + AL((size_t)MT * 48 * 4);
constexpr size_t HGS1 = (size_t)(MT / 16) * 1024 * 4;
constexpr size_t WS_MEMB = WS_HGS + AL(3 * HGS1);
constexpr size_t WS_KMEM = WS_MEMB + AL((size_t)4096 * 1024 * 2);
constexpr size_t WS_VTMEM = WS_KMEM + AL((size_t)4096 * 1024 * 2);
constexpr size_t WS_WAIN = WS_VTMEM + AL((size_t)4096 * 1024 * 2);
constexpr size_t WS_WAOUT = WS_WAIN + AL((size_t)2 * 4096 * 1024 * 2);
constexpr size_t WS_WBIN = WS_WAOUT + AL((size_t)2 * 1024 * 1024 * 2);
constexpr size_t WS_WBOUT = WS_WBIN + AL((size_t)9216 * 1024 * 2);
constexpr size_t WS_WGLU = WS_WBOUT + AL((size_t)1024 * 1024 * 2);
constexpr size_t WS_WKV = WS_WGLU + AL((size_t)2048 * 1024 * 2);
constexpr size_t WS_WQ = WS_WKV + AL((size_t)2048 * 1024 * 2);
constexpr size_t WS_WO = WS_WQ + AL((size_t)4 * 1024 * 1024 * 2);
constexpr size_t WS_W1 = WS_WO + AL((size_t)4 * 1024 * 1024 * 2);
constexpr size_t WS_W2 = WS_W1 + AL((size_t)128 * 2048 * 1024 * 2);
constexpr size_t ACT1 = (size_t)MT * 1024 * 2;
constexpr size_t WS_H = WS_W2 + AL((size_t)128 * 1024 * 1024 * 2);
constexpr size_t WS_MIX = WS_H + ACT1;
constexpr size_t WS_T0 = WS_MIX + ACT1;
constexpr size_t WS_T1 = WS_T0 + ACT1;
constexpr size_t WS_WAIN8 = WS_T1 + ACT1;
constexpr size_t WS_H8 = WS_WAIN8 + AL((size_t)2 * 4096 * 1024);
constexpr size_t WS_BIG = WS_H8 + ACT1 / 2;
constexpr size_t BA_Q = 0, BA_E1 = ACT1, BA_KI = 2 * ACT1, BA_VT = 3 * ACT1, BA_G = 4 * ACT1, BA_KIT = 5 * ACT1;
constexpr size_t BB_PROJ = 0, BB_OG = (size_t)MT * 9216 * 2;
constexpr size_t MOE1 = (size_t)NSLOT * 1024 * 2;
constexpr size_t BM_XS = 0, BM_ACT = MOE1, BM_YS = 2 * MOE1;
constexpr size_t BIG_BYTES = 3 * MOE1 > (BB_OG + 3 * ACT1) ? 3 * MOE1 : (BB_OG + 3 * ACT1);
constexpr size_t WS_END = WS_BIG + BIG_BYTES;

struct Params {
    const float* in[29]; const int* pos; float* out; unsigned char* ws;
    int lo, hi, li, pad;
};

__device__ __forceinline__ float bf2f(bf16_t v) { return __uint_as_float(((unsigned)v) << 16); }
__device__ __forceinline__ bf16_t f2bf(float f) { unsigned u = __float_as_uint(f); u += 0x7FFFu + ((u >> 16) & 1u); return (bf16_t)(u >> 16); }
__device__ __forceinline__ unsigned pk2(float lo, float hi) { return pg8::cvt_pk_bf16(lo, hi); }
__device__ __forceinline__ unsigned pk4_fp8(float a, float b, float c, float d) { int w = 0; w = __builtin_amdgcn_cvt_pk_fp8_f32(a, b, w, false); w = __builtin_amdgcn_cvt_pk_fp8_f32(c, d, w, true); return (unsigned)w; }
__device__ __forceinline__ f32x2 fp8x2_lo(unsigned w) { return __builtin_amdgcn_cvt_pk_f32_fp8((int)w, false); }
__device__ __forceinline__ f32x2 fp8x2_hi(unsigned w) { return __builtin_amdgcn_cvt_pk_f32_fp8((int)w, true); }
__device__ __forceinline__ u32x4 f8x8_to_bf16x8(u32x2 w) {
    const f32x2 a = fp8x2_lo(w.x), b = fp8x2_hi(w.x), c = fp8x2_lo(w.y), d = fp8x2_hi(w.y);
    u32x4 r; r.x = pg8::cvt_pk_bf16(a.x, a.y); r.y = pg8::cvt_pk_bf16(b.x, b.y); r.z = pg8::cvt_pk_bf16(c.x, c.y); r.w = pg8::cvt_pk_bf16(d.x, d.y); return r; }
__device__ __forceinline__ float lo16(unsigned w) { return __uint_as_float(w << 16); }
__device__ __forceinline__ float hi16(unsigned w) { return __uint_as_float(w & 0xffff0000u); }
__device__ __forceinline__ float sigmoidf_(float x) { return __builtin_amdgcn_rcpf(1.0f + __expf(-x)); }
__device__ __forceinline__ float siluf_(float x) { return x * __builtin_amdgcn_rcpf(1.0f + __expf(-x)); }
__device__ __forceinline__ float gelu_tanh(float y) {
    const float a = y * __builtin_fmaf(y * y, -0.10294323f, -2.3022082f); return y * __builtin_amdgcn_rcpf(1.0f + __builtin_amdgcn_exp2f(a)); }
__device__ __forceinline__ f32x4 mfma32(bf16x8 a, bf16x8 b, f32x4 c) { return __builtin_amdgcn_mfma_f32_16x16x32_bf16(a, b, c, 0, 0, 0); }
#ifndef DBG_NO_MFMA16
#define DBG_NO_MFMA16 1
#endif
__device__ __forceinline__ f32x4 mfma16(bf16x4 a, bf16x4 b, f32x4 c) {
#if DBG_NO_MFMA16
    const bf16x8 a8 = {a[0], a[1], a[2], a[3], 0, 0, 0, 0}, b8 = {b[0], b[1], b[2], b[3], 0, 0, 0, 0};
    return __builtin_amdgcn_mfma_f32_16x16x32_bf16(a8, b8, c, 0, 0, 0);
#else
    return __builtin_amdgcn_mfma_f32_16x16x16bf16_1k(a, b, c, 0, 0, 0);
#endif
}
__device__ __forceinline__ bf16x8 mk8(u32x2 a, u32x2 b) { u32x4 w; w.x = a.x; w.y = a.y; w.z = b.x; w.w = b.y; return __builtin_bit_cast(bf16x8, w); }
__device__ __forceinline__ bf16x8 mk8f(f32x4 a, f32x4 b) { u32x4 w; w.x = pk2(a[0], a[1]); w.y = pk2(a[2], a[3]); w.z = pk2(b[0], b[1]); w.w = pk2(b[2], b[3]); return __builtin_bit_cast(bf16x8, w); }
__device__ __forceinline__ bf16x4 mk4f(f32x4 a) { u32x2 w; w.x = pk2(a[0], a[1]); w.y = pk2(a[2], a[3]); return __builtin_bit_cast(bf16x4, w); }

template <bool OUT8 = false> struct EpiPlainT {
    static constexpr bool PERM = true, AFTER_DRAIN = false;
    bf16_t* O; int ldc; int ntn; const float* bias; int bias_stride;
    __device__ __forceinline__ void operator()(const f32x4 (&acc)[2][2][4][2], const pg8::Unit& u, int wr, int wc, int fr, int fq) const {
        const int mat = u.pn / ntn, pnl = u.pn - mat * ntn;
        const int row0 = u.pm * 256 + wr * 64 + fr, col0 = pnl * 256 + wc * 32 + 8 * fq;
        f32x4 bv[2][2];
#pragma unroll
        for (int bj = 0; bj < 2; ++bj)
#pragma unroll
            for (int n = 0; n < 2; ++n) bv[bj][n] = bias ? *(const f32x4*)(bias + (size_t)mat * bias_stride + col0 + bj * 128 + 4 * n) : (f32x4){0.f, 0.f, 0.f, 0.f};
#pragma unroll
        for (int ai = 0; ai < 2; ++ai)
#pragma unroll
            for (int m = 0; m < 4; ++m) { const size_t ro = (size_t)(row0 + ai * 128 + m * 16) * ldc + col0;
#pragma unroll
                for (int bj = 0; bj < 2; ++bj) { const f32x4 v0 = acc[ai][bj][m][0] + bv[bj][0], v1 = acc[ai][bj][m][1] + bv[bj][1];
                    if (OUT8) { u32x2 w8; w8.x = pk4_fp8(v0[0], v0[1], v0[2], v0[3]); w8.y = pk4_fp8(v1[0], v1[1], v1[2], v1[3]); *(u32x2*)((unsigned char*)O + ro + bj * 128) = w8; }
                    else { u32x4 w; w.x = pk2(v0[0], v0[1]); w.y = pk2(v0[2], v0[3]); w.z = pk2(v1[0], v1[1]); w.w = pk2(v1[2], v1[3]);
                        *(u32x4*)(O + ro + bj * 128) = w; } } }
    }
};
typedef EpiPlainT<false> EpiPlain;
struct EpiHgrn {
    static constexpr bool PERM = true, AFTER_DRAIN = false;
    unsigned char* big; const float* lb; float* hgs; int secmap; LAS unsigned char* tl;
    __device__ __forceinline__ void store_t(bf16_t* dstT, size_t step, int col0, const u32x4 (&wt)[2], LAS unsigned char* tb, int fr) const {
        *(LAS u32x4*)(tb + fr * 32) = wt[0]; *(LAS u32x4*)(tb + fr * 32 + 16) = wt[1];
        u32x2 tq[4];
#pragma unroll
        for (int tg = 0; tg < 4; ++tg) tq[tg] = __builtin_bit_cast(u32x2, __builtin_amdgcn_ds_read_tr16_b64_v4i16((LAS bf16x4*)(tb + (4 * tg + (fr >> 2)) * 32 + (fr & 3) * 8)));
        bf16_t* tp = dstT + (step * 1024 + col0 + (fr & 7) + (fr >> 3) * 128) * 16;
        *(u32x4*)tp = (u32x4){tq[0].x, tq[0].y, tq[1].x, tq[1].y}; *(u32x4*)(tp + 8) = (u32x4){tq[2].x, tq[2].y, tq[3].x, tq[3].y};
    }
    __device__ __forceinline__ void operator()(const f32x4 (&acc)[2][2][4][2], const pg8::Unit& u, int wr, int wc, int fr, int fq) const {
        const int sec = (secmap >> (4 * (u.pn >> 2))) & 15, pnl = u.pn & 3;
        LAS unsigned char* tb = tl + (wr * 4 + wc) * 2048 + fq * 512;
        const int row0 = u.pm * 256 + wr * 64 + fr, col0 = pnl * 256 + wc * 32 + 8 * fq;
        f32x4 lbv[2][2];
#pragma unroll
        for (int bj = 0; bj < 2; ++bj)
#pragma unroll
            for (int n = 0; n < 2; ++n) lbv[bj][n] = *(const f32x4*)(lb + col0 + bj * 128 + 4 * n);
#pragma unroll
        for (int ai = 0; ai < 2; ++ai)
#pragma unroll
            for (int m = 0; m < 4; ++m) { const size_t ro = (size_t)(row0 + ai * 128 + m * 16) * 1024 + col0;
#pragma unroll
                for (int bj = 0; bj < 2; ++bj) { f32x4 v0 = acc[ai][bj][m][0], v1 = acc[ai][bj][m][1];
                    if (sec == 1) {
                        f32x4 e1v[2], kiv[2], fgv[2];
#pragma unroll
                        for (int n = 0; n < 2; ++n)
#pragma unroll
                            for (int e = 0; e < 4; ++e) { const float l = lbv[bj][n][e]; const float x = n == 0 ? v0[e] : v1[e];
                                const float fg = fmaxf(l + (1.0f - l) * sigmoidf_(x), 1e-6f); const float kk = 1.0f - fg;
                                float c = fr == 0 ? 1.0f : fg;
                                c *= __int_as_float(__builtin_amdgcn_update_dpp(0x3f800000, __float_as_int(c), 0x111, 0xf, 0xf, false));
                                c *= __int_as_float(__builtin_amdgcn_update_dpp(0x3f800000, __float_as_int(c), 0x112, 0xf, 0xf, false));
                                c *= __int_as_float(__builtin_amdgcn_update_dpp(0x3f800000, __float_as_int(c), 0x114, 0xf, 0xf, false));
                                c *= __int_as_float(__builtin_amdgcn_update_dpp(0x3f800000, __float_as_int(c), 0x118, 0xf, 0xf, false));
                                e1v[n][e] = c; kiv[n][e] = kk * fminf(__builtin_amdgcn_rcpf(c), 5.5406224e34f); fgv[n][e] = fg; }
                        u32x4 w; w.x = pk2(e1v[0][0], e1v[0][1]); w.y = pk2(e1v[0][2], e1v[0][3]); w.z = pk2(e1v[1][0], e1v[1][1]); w.w = pk2(e1v[1][2], e1v[1][3]);
                        *(u32x4*)((bf16_t*)(big + BA_E1) + ro + bj * 128) = w;
                        w.x = pk2(kiv[0][0], kiv[0][1]); w.y = pk2(kiv[0][2], kiv[0][3]); w.z = pk2(kiv[1][0], kiv[1][1]); w.w = pk2(kiv[1][2], kiv[1][3]);
                        *(u32x4*)((bf16_t*)(big + BA_KI) + ro + bj * 128) = w;
                        if (fr == 0 || fr == 15) { float* sp = hgs + (fr == 0 ? HGS1 / 4 : 2 * (HGS1 / 4)) + (size_t)((row0 - fr + ai * 128 + m * 16) >> 4) * 1024 + col0 + bj * 128;
                            *(f32x4*)sp = fr == 0 ? fgv[0] : e1v[0]; *(f32x4*)(sp + 4) = fr == 0 ? fgv[1] : e1v[1]; }
                    } else {
                        if (sec != 2) {
#pragma unroll
                            for (int e = 0; e < 4; ++e) { v0[e] = siluf_(v0[e]); v1[e] = siluf_(v1[e]); } }
                        u32x4 w; w.x = pk2(v0[0], v0[1]); w.y = pk2(v0[2], v0[3]); w.z = pk2(v1[0], v1[1]); w.w = pk2(v1[2], v1[3]);
                        { bf16_t* dst = (bf16_t*)(big + (sec == 0 ? BA_Q : (sec == 2 ? BA_VT : BA_G))); *(u32x4*)(dst + ro + bj * 128) = w; } } }
                }
    }
};
struct EpiRope {
    static constexpr bool PERM = true, AFTER_DRAIN = false;
    bf16_t* O; const int* pos; const float* tab;
    __device__ __forceinline__ void operator()(const f32x4 (&acc)[2][2][4][2], const pg8::Unit& u, int wr, int wc, int fr, int fq) const {
        const int sec = u.pn >> 2, type = sec % 3;
        const int row0 = u.pm * 256 + wr * 64 + fr, col0 = u.pn * 256 + wc * 32 + 8 * fq;
        const int i0 = (wc & 1) * 16 + 4 * fq;
#pragma unroll
        for (int ai = 0; ai < 2; ++ai)
#pragma unroll
            for (int m = 0; m < 4; ++m) { const int row = row0 + ai * 128 + m * 16; bf16_t* rowp = O + (size_t)row * 9216 + col0;
                f32x4 cs0 = {1.f, 0.f, 1.f, 0.f}, cs1 = {1.f, 0.f, 1.f, 0.f};
                if (type < 2) { int pp = pos[row]; pp = pp < 0 ? 0 : (pp >= ROPE_POS ? ROPE_POS - 1 : pp); const float* tp = tab + ((size_t)pp * 32 + i0) * 2; cs0 = *(const f32x4*)tp; cs1 = *(const f32x4*)(tp + 4); }
#pragma unroll
                for (int bj = 0; bj < 2; ++bj) { const f32x4 v0 = acc[ai][bj][m][0], v1 = acc[ai][bj][m][1];
                    u32x4 w;
                    w.x = pk2(v0[0] * cs0[0] - v0[1] * cs0[1], v0[0] * cs0[1] + v0[1] * cs0[0]);
                    w.y = pk2(v0[2] * cs0[2] - v0[3] * cs0[3], v0[2] * cs0[3] + v0[3] * cs0[2]);
                    w.z = pk2(v1[0] * cs1[0] - v1[1] * cs1[1], v1[0] * cs1[1] + v1[1] * cs1[0]);
                    w.w = pk2(v1[2] * cs1[2] - v1[3] * cs1[3], v1[2] * cs1[3] + v1[3] * cs1[2]);
                    u32x2 w8; w8.x = pk4_fp8(lo16(w.x), hi16(w.x), lo16(w.y), hi16(w.y)); w8.y = pk4_fp8(lo16(w.z), hi16(w.z), lo16(w.w), hi16(w.w));
                    *(u32x2*)((unsigned char*)O + (size_t)row * 9216 + col0 + bj * 128) = w8; } }
    }
};
template <int MODE, bool OUT8 = false> struct EpiGlu {
    static constexpr bool PERM = true, AFTER_DRAIN = false;
    struct State { u32x4 ba, bb; };
    bf16_t* O; const bf16_t* bias;
    __device__ __forceinline__ void pre(const pg8::Unit& u, int wc, int fq, State& s) const {
        const int mat = u.pn >> 3, pnl = u.pn & 7, col0 = pnl * 128 + wc * 32 + 8 * fq;
        s.ba = *(const u32x4*)(bias + (size_t)mat * 2048 + col0); s.bb = *(const u32x4*)(bias + (size_t)mat * 2048 + 1024 + col0); }
    __device__ __forceinline__ void operator()(const f32x4 (&acc)[2][2][4][2], const pg8::Unit& u, int wr, int wc, int fr, int fq) const { State s; s.ba = (u32x4){0u, 0u, 0u, 0u}; s.bb = s.ba; (*this)(acc, u, wr, wc, fr, fq, s); }
    __device__ __forceinline__ void operator()(const f32x4 (&acc)[2][2][4][2], const pg8::Unit& u, int wr, int wc, int fr, int fq, const State& s) const {
        const int pnl = u.pn & 7;
        const int row0 = u.pm * 256 + wr * 64 + fr, col0 = pnl * 128 + wc * 32 + 8 * fq;
        f32x4 ba[2], bb[2];
        ba[0] = (f32x4){lo16(s.ba.x), hi16(s.ba.x), lo16(s.ba.y), hi16(s.ba.y)}; ba[1] = (f32x4){lo16(s.ba.z), hi16(s.ba.z), lo16(s.ba.w), hi16(s.ba.w)};
        bb[0] = (f32x4){lo16(s.bb.x), hi16(s.bb.x), lo16(s.bb.y), hi16(s.bb.y)}; bb[1] = (f32x4){lo16(s.bb.z), hi16(s.bb.z), lo16(s.bb.w), hi16(s.bb.w)};
#pragma unroll
        for (int ai = 0; ai < 2; ++ai)
#pragma unroll
            for (int m = 0; m < 4; ++m) { bf16_t* rowp = O + (size_t)(row0 + ai * 128 + m * 16) * 1024 + col0;
                f32x4 r[2];
#pragma unroll
                for (int n = 0; n < 2; ++n) { const f32x4 a = acc[ai][0][m][n] + ba[n], g = acc[ai][1][m][n] + bb[n];
                    if (MODE == 0) {
#pragma unroll
                        for (int e = 0; e < 4; ++e) r[n][e] = a[e] * sigmoidf_(g[e]);
                    } else {
#pragma unroll
                        for (int e = 0; e < 4; e += 2) {
                            const f32x2 hg = {fminf(a[e], 7.0f), fminf(a[e + 1], 7.0f)}, hl = {__builtin_amdgcn_fmed3f(g[e], -7.0f, 7.0f), __builtin_amdgcn_fmed3f(g[e + 1], -7.0f, 7.0f)};
                            const f32x2 t = hg * (-1.702f * 1.4426950408889634f);
                            f32x2 ex; ex.x = __builtin_amdgcn_exp2f(t.x); ex.y = __builtin_amdgcn_exp2f(t.y);
                            const f32x2 den = ex + 1.0f; f32x2 sg; sg.x = __builtin_amdgcn_rcpf(den.x); sg.y = __builtin_amdgcn_rcpf(den.y);
                            const f32x2 o2 = (hg * sg) * (hl + 1.0f); r[n][e] = o2.x; r[n][e + 1] = o2.y; } } }
                if (OUT8) { u32x2 w8; w8.x = pk4_fp8(r[0][0], r[0][1], r[0][2], r[0][3]); w8.y = pk4_fp8(r[1][0], r[1][1], r[1][2], r[1][3]);
                    *(u32x2*)((unsigned char*)O + (size_t)(row0 + ai * 128 + m * 16) * 1024 + col0) = w8; }
                else { u32x4 w; w.x = pk2(r[0][0], r[0][1]); w.y = pk2(r[0][2], r[0][3]); w.z = pk2(r[1][0], r[1][1]); w.w = pk2(r[1][2], r[1][3]);
                    *(u32x4*)rowp = w; } }
    }
};
struct MoeOrder {
    int G, c, ntn, NT; const LAS unsigned char* tile_e; const LAS int* mi; const int* list; unsigned rowpitch; const LAS unsigned short* rowidx;
    __device__ __forceinline__ void unit_rows(const pg8::Unit& u, int& e, int& i0, int& cn) const { e = (int)tile_e[u.pm]; i0 = (u.pm - mi[1 + e]) * 256; cn = mi[40 + e]; }
    __device__ __forceinline__ int row_tok(int e, int idx, int cn) const { const int ic = idx < cn ? idx : cn - 1; return list[(size_t)e * 65536 + ic]; }
    __device__ __forceinline__ unsigned row_bytes(int e, int idx, int cn) const { return (unsigned)row_tok(e, idx, cn) * rowpitch; }
    __device__ __forceinline__ bool next(int i, pg8::Unit& u) const {
        int rt, pn;
        if (G == 256) { const int x = c & 7, s = c >> 3, rpx = 32 / ntn; rt = i * (256 / ntn) + x * rpx + s / ntn; pn = s % ntn; }
        else { const long L = (long)i * G + c; rt = (int)(L / ntn); pn = (int)(L % ntn); }
        if (rt >= NT) return false;
        u.pm = rt; u.pn = (int)tile_e[rt] * ntn + pn; return true;
    }
    __device__ __forceinline__ void a_ready(const pg8::Unit&) const {}
    __device__ __forceinline__ void done(const pg8::Unit&) const {}
};

#ifndef FP8_DIL
#define FP8_DIL 1
#endif
#ifndef FP8_HGRN
#define FP8_HGRN 0
#endif
#ifndef FP8_MIX
#define FP8_MIX 1
#endif
#ifndef FP8_DILOUT
#define FP8_DILOUT 1
#endif
#ifndef FP8_HGRN_QI
#define FP8_HGRN_QI 1
#endif
#ifndef FP8_HGRN_G
#define FP8_HGRN_G 0
#endif
#ifndef FP8_GLU
#define FP8_GLU 1
#endif
#ifndef FP8_Q
#define FP8_Q 1
#endif
#ifndef FP8_O
#define FP8_O 1
#endif
#ifndef FP8_MIXOUT
#define FP8_MIXOUT 0
#endif
#ifndef DBG_MASK
#define DBG_MASK 31
#endif
#define DBG_NO_MOE (!(DBG_MASK & 16))
#define DBG_SKIP_CROSS 0
#define DBG_TRIVIAL_SCAN 0
#define DBG_HGRN_SAFE 0
#define DBG_TRIVIAL_IN 0
__device__ __forceinline__ int l_tid() { int t = threadIdx.x; asm volatile("" : "+v"(t)); return t; }
__device__ __forceinline__ int l_bid() { int b = blockIdx.x; asm volatile("" : "+s"(b)); return b; }
__device__ __forceinline__ int l_gdim() { int g = gridDim.x; asm volatile("" : "+s"(g)); return g; }
#define LAUNDER_IDS() const int TIDX = l_tid(), BIDX = l_bid(), GDIMX = l_gdim(); (void)TIDX; (void)BIDX; (void)GDIMX

__device__ __forceinline__ int map_row(int mode, int n) {
    if (mode == 1) { const int sec = n >> 10; if ((sec % 3) == 2) return n; const int j = n & 63; const int jj = (j < 32) ? 2 * j : 2 * (j - 32) + 1; return (n & ~63) | jj; }
    if (mode == 2) { const int half = n >> 10, j = n & 1023; return ((j >> 7) << 8) | (half << 7) | (j & 127); }
    if (mode == 3) { const int s = n >> 10; const int d = s == 0 ? 0 : (s == 1 ? 3 : s - 1); return (d << 10) | (n & 1023); }
    if (mode == 4) { if (n < 1024) return n; const int d = n & 255; return (n & ~255) | (((d >> 2) & 15) << 4) | ((d >> 6) << 2) | (d & 3); }
    return n;
}
__device__ __forceinline__ void conv_group(LAS unsigned char* lds, const float* src, bf16_t* dst, int njobs, int N, int mode) {
    LAUNDER_IDS();
    LAS bf16_t* T = (LAS bf16_t*)lds;
    const int tid = TIDX; const int tn = N / 64, tpj = 16 * tn; const long total = (long)njobs * tpj;
    const int lk = tid >> 4, ln4 = (tid & 15) * 4;
    f32x4 na0 = {0.f, 0.f, 0.f, 0.f}, na1 = na0, nb0 = na0, nb1 = na0;
#define CG_FETCH(n0_, n1_, t_) do { const long tt_ = (t_) < total ? (t_) : (long)BIDX % total; const int job_ = (int)(tt_ / tpj), r_ = (int)(tt_ % tpj), kt_ = r_ / tn, nt_ = r_ % tn; \
        const float* s_ = src + (size_t)job_ * 1024 * N + (size_t)(kt_ * 64) * N + nt_ * 64; n0_ = *(const f32x4*)(s_ + (size_t)lk * N + ln4); n1_ = *(const f32x4*)(s_ + (size_t)(lk + 32) * N + ln4); } while (0)
#define CG_PROC(n0_, n1_, t_, tnext_) do { const long tc_ = (t_); const int job = (int)(tc_ / tpj), r = (int)(tc_ % tpj), kt = r / tn, nt = r % tn; \
        const f32x4 v0 = n0_, v1 = n1_; \
        CG_FETCH(n0_, n1_, tnext_); \
        T[(ln4 + 0) * 72 + lk] = f2bf(v0[0]); T[(ln4 + 1) * 72 + lk] = f2bf(v0[1]); T[(ln4 + 2) * 72 + lk] = f2bf(v0[2]); T[(ln4 + 3) * 72 + lk] = f2bf(v0[3]); \
        T[(ln4 + 0) * 72 + lk + 32] = f2bf(v1[0]); T[(ln4 + 1) * 72 + lk + 32] = f2bf(v1[1]); T[(ln4 + 2) * 72 + lk + 32] = f2bf(v1[2]); T[(ln4 + 3) * 72 + lk + 32] = f2bf(v1[3]); \
        __syncthreads(); \
        { const int n = tid >> 3, kc = (tid & 7) * 8; const u32x4 w = *(const LAS u32x4*)(T + n * 72 + kc); \
          const int nn = map_row(mode, nt * 64 + n); \
          *(u32x4*)(dst + (size_t)job * N * 1024 + (size_t)nn * 1024 + kt * 64 + kc) = w; } \
        __syncthreads(); } while (0)
    if ((long)BIDX < total) { CG_FETCH(na0, na1, (long)BIDX); CG_FETCH(nb0, nb1, (long)BIDX + GDIMX); }
    for (long t = BIDX; t < total; t += 2 * (long)GDIMX) {
        CG_PROC(na0, na1, t, t + 2 * (long)GDIMX);
        if (t + GDIMX < total) CG_PROC(nb0, nb1, t + GDIMX, t + 3 * (long)GDIMX);
    }
#undef CG_FETCH
#undef CG_PROC
}
__device__ __forceinline__ void conv_group8(LAS unsigned char* lds, const float* src, unsigned char* dst, int njobs, int N, int mode, float scale, int vbid = -1, int vgrid = 0) {
    const int TIDX = l_tid(), BIDX = vbid >= 0 ? vbid : l_bid(), GDIMX = vbid >= 0 ? vgrid : l_gdim();
    LAS unsigned char* T = lds;
    const int tid = TIDX; const int tn = N / 128, tpj = 16 * tn; const long total = (long)njobs * tpj;
    const int kb = tid & 15, nb = tid >> 4;
    f32x4 nva[4], nvb[4];
#define CG_FETCH(nv_, t_) do { const long tt_ = (t_) < total ? (t_) : (long)BIDX % total; const int job_ = (int)(tt_ / tpj), r_ = (int)(tt_ % tpj), kt_ = r_ / tn, nt_ = r_ % tn; \
        const float* s_ = src + (size_t)job_ * 1024 * N + (size_t)(kt_ * 64 + 4 * kb) * N + nt_ * 128 + 4 * nb; \
        _Pragma("unroll") for (int i = 0; i < 4; ++i) nv_[i] = *(const f32x4*)(s_ + (size_t)i * N); } while (0)
#define CG_PROC(nv_, t_, tnext_) do { const long tc_ = (t_); const int job = (int)(tc_ / tpj), r = (int)(tc_ % tpj), kt = r / tn, nt = r % tn; \
        f32x4 v[4]; _Pragma("unroll") for (int i = 0; i < 4; ++i) v[i] = nv_[i] * scale; \
        CG_FETCH(nv_, tnext_); \
        _Pragma("unroll") for (int e = 0; e < 4; ++e) *(LAS unsigned*)(T + (4 * nb + e) * 80 + 4 * kb) = pk4_fp8(v[0][e], v[1][e], v[2][e], v[3][e]);     \
        __syncthreads(); \
        { const int n = tid >> 2, kc = (tid & 3) * 16; const u32x4 w = *(const LAS u32x4*)(T + n * 80 + kc); \
          const int nn = map_row(mode, nt * 128 + n); \
          *(u32x4*)(dst + (size_t)job * N * 1024 + (size_t)nn * 1024 + kt * 64 + kc) = w; } \
        __syncthreads(); } while (0)
    if ((long)BIDX < total) { CG_FETCH(nva, (long)BIDX); CG_FETCH(nvb, (long)BIDX + GDIMX); }
    for (long t = BIDX; t < total; t += 2 * (long)GDIMX) {
        CG_PROC(nva, t, t + 2 * (long)GDIMX);
        if (t + GDIMX < total) CG_PROC(nvb, t + GDIMX, t + 3 * (long)GDIMX);
    }
#undef CG_FETCH
#undef CG_PROC
}
__device__ __forceinline__ void cvt_rows(const float* src, bf16_t* dst, size_t n8) {
    LAUNDER_IDS();
    for (size_t i = (size_t)BIDX * 512 + TIDX; i < n8; i += (size_t)GDIMX * 512) {
        const f32x4 a = *(const f32x4*)(src + i * 8), b = *(const f32x4*)(src + i * 8 + 4);
        u32x4 w; w.x = pk2(a[0], a[1]); w.y = pk2(a[2], a[3]); w.z = pk2(b[0], b[1]); w.w = pk2(b[2], b[3]);
        *(u32x4*)(dst + i * 8) = w; }
}
__device__ __forceinline__ void prologue_phase(const Params& p, LAS unsigned char* lds) {
    LAUNDER_IDS();
    unsigned char* ws = p.ws;
    conv_group8(lds, p.in[25], ws + WS_W1, 96, 2048, 2, 64.0f);
    conv_group8(lds, p.in[27], ws + WS_W2, 96, 1024, 0, 64.0f);
    conv_group(lds, p.in[5], (bf16_t*)(ws + WS_WAIN), 2, 4096, 0);
#if FP8_HGRN || FP8_HGRN_G || FP8_HGRN_QI
    conv_group8(lds, p.in[5], ws + WS_WAIN8, 2, 4096, 3, 64.0f);
#endif
#if FP8_MIXOUT
    conv_group8(lds, p.in[8], ws + WS_WAOUT, 2, 1024, 0, 64.0f);
#else
    conv_group(lds, p.in[8], (bf16_t*)(ws + WS_WAOUT), 2, 1024, 0);
#endif
#if FP8_DIL
    conv_group8(lds, p.in[9], ws + WS_WBIN, 1, 9216, 1, 64.0f);
#else
    conv_group(lds, p.in[9], (bf16_t*)(ws + WS_WBIN), 1, 9216, 1);
#endif
#if FP8_MIXOUT || FP8_DILOUT
    conv_group8(lds, p.in[10], ws + WS_WBOUT, 1, 1024, 0, 64.0f);
#else
    conv_group(lds, p.in[10], (bf16_t*)(ws + WS_WBOUT), 1, 1024, 0);
#endif
#if FP8_GLU
    conv_group8(lds, p.in[19], ws + WS_WGLU, 1, 2048, 2, 64.0f);
#else
    conv_group(lds, p.in[19], (bf16_t*)(ws + WS_WGLU), 1, 2048, 2);
#endif
    conv_group(lds, p.in[20], (bf16_t*)(ws + WS_WKV), 1, 2048, 4);
#if FP8_Q
    conv_group8(lds, p.in[21], ws + WS_WQ, 4, 1024, 0, 64.0f);
#else
    conv_group(lds, p.in[21], (bf16_t*)(ws + WS_WQ), 4, 1024, 0);
#endif
#if FP8_O
    conv_group8(lds, p.in[22], ws + WS_WO, 4, 1024, 0, 64.0f);
#else
    conv_group(lds, p.in[22], (bf16_t*)(ws + WS_WO), 4, 1024, 0);
#endif
    { const size_t n8 = (size_t)MT * 1024 / 8, gs = (size_t)GDIMX * 512;
      for (size_t i0 = (size_t)BIDX * 512 + TIDX; i0 < n8; i0 += 4 * gs) {
        f32x4 a[4], b2[4];
#pragma unroll
        for (int u = 0; u < 4; ++u) { const size_t i = i0 + u * gs < n8 ? i0 + u * gs : i0; a[u] = *(const f32x4*)(p.in[0] + i * 8); b2[u] = *(const f32x4*)(p.in[0] + i * 8 + 4); }
#pragma unroll
        for (int u = 0; u < 4; ++u) { const size_t i = i0 + u * gs; if (i < n8) {
            u32x4 wh; wh.x = pk2(a[u][0], a[u][1]); wh.y = pk2(a[u][2], a[u][3]); wh.z = pk2(b2[u][0], b2[u][1]); wh.w = pk2(b2[u][2], b2[u][3]); *(u32x4*)(ws + WS_H + i * 16) = wh;
            u32x2 w; w.x = pk4_fp8(a[u][0], a[u][1], a[u][2], a[u][3]); w.y = pk4_fp8(b2[u][0], b2[u][1], b2[u][2], b2[u][3]); *(u32x2*)(ws + WS_H8 + i * 8) = w; } } } }
    cvt_rows(p.in[1], (bf16_t*)(ws + WS_MEMB), (size_t)4096 * 1024 / 8);
    const size_t gtid = (size_t)BIDX * 512 + TIDX, gsz = (size_t)GDIMX * 512;
    for (size_t i = gtid; i < (size_t)4 * 32 * 2048; i += gsz) ((bf16_t*)(ws + WS_B1H))[i] = f2bf(p.in[26][i]);
    for (size_t i = gtid; i < (size_t)4 * 32 * 1024; i += gsz) ((bf16_t*)(ws + WS_B2H))[i] = f2bf(p.in[28][i]);
    for (size_t i = gtid; i < 1024; i += gsz) { const float* a = p.in[6]; const float v0 = a[i], v1 = a[1024 + i], v2 = a[2048 + i], v3 = a[3072 + i];
        const float mx = fmaxf(fmaxf(v0, v1), fmaxf(v2, v3)); const float e0 = expf(v0 - mx), e1 = expf(v1 - mx), e2 = expf(v2 - mx), e3 = expf(v3 - mx); const float s = e0 + e1 + e2 + e3;
        float* lb = (float*)(ws + WS_LB); lb[i] = 0.0f; lb[1024 + i] = (e1 + e2 + e3) / s; }
    for (size_t i = gtid; i < (size_t)4 * 32 * 1024; i += gsz) { const int l = (int)(i >> 15), e = (int)((i >> 10) & 31), k = (int)(i & 1023);
        const float w = p.in[23][((size_t)l * 1024 + k) * 32 + e]; const bf16_t hi = f2bf(w); ((bf16_t*)(ws + WS_WRHI))[i] = hi; ((bf16_t*)(ws + WS_WRLO))[i] = f2bf(w - bf2f(hi)); }
    for (size_t i = gtid; i < (size_t)ROPE_POS * 32; i += gsz) { const int pp = (int)(i >> 5), f = (int)(i & 31);
        const float invf = (float)pow(10000.0, -(double)f / 32.0); const float ang = (float)pp * invf; const double a = (double)ang;
        float* t = (float*)(ws + WS_ROPE); t[i * 2] = (float)cos(a); t[i * 2 + 1] = (float)sin(a); }
    for (size_t i = gtid; i < 64 * 64; i += gsz) { const int g = (int)(i >> 6);
        const double ar = p.in[11][i], ai = p.in[12][i], dt = exp((double)p.in[13][g]);
        const double mag = exp(ar * dt), lr = mag * cos(ai * dt), li = mag * sin(ai * dt), den = ar * ar + ai * ai;
        const double fr = ((lr - 1.0) * ar + li * ai) / den, fi = (li * ar - (lr - 1.0) * ai) / den;
        float* lam = (float*)(ws + WS_S5LAM); lam[i * 2] = (float)lr; lam[i * 2 + 1] = (float)li;
        float* bbp = (float*)(ws + WS_S5BB) + i * 32;
        bf16_t* btp = (bf16_t*)(ws + WS_S5BT) + (size_t)g * 128 * 16; const int n = (int)(i & 63);
        for (int c = 0; c < 16; ++c) { const double br = p.in[14][i * 16 + c], bi = p.in[15][i * 16 + c]; const float vr = (float)(fr * br - fi * bi), vi = (float)(fr * bi + fi * br);
            bbp[c] = vr; bbp[16 + c] = vi; btp[n * 16 + c] = f2bf(vr); btp[(64 + n) * 16 + c] = f2bf(vi); } }
    for (size_t i = gtid; i < (size_t)64 * 16 * 128; i += gsz) { const int k = (int)(i & 127), gc = (int)(i >> 7);
        const float v = (k < 64) ? p.in[16][(size_t)gc * 64 + k] : -p.in[17][(size_t)gc * 64 + (k - 64)]; ((bf16_t*)(ws + WS_S5C))[i] = f2bf(v); }
}


__device__ __forceinline__ void dbg_scan_phase(const Params& p) {
    LAUNDER_IDS();
    unsigned char* ws = p.ws; unsigned* flag = (unsigned*)(ws + CTL_CNT) + 512;
    const size_t gtid = (size_t)BIDX * 512 + TIDX, gsz = (size_t)GDIMX * 512; unsigned f = 0;
    const bf16_t* K = (const bf16_t*)(ws + WS_KMEM); const bf16_t* VT = (const bf16_t*)(ws + WS_VTMEM); const bf16_t* Q = (const bf16_t*)(ws + WS_T0); const bf16_t* O = (const bf16_t*)(ws + WS_T1);
    for (size_t i = gtid; i < (size_t)4096 * 1024; i += gsz) { if ((K[i] & 0x7F80) == 0x7F80) f |= 1u; if ((VT[i] & 0x7F80) == 0x7F80) f |= 2u; }
    for (size_t i = gtid; i < (size_t)MT * 1024; i += gsz) { if ((Q[i] & 0x7F80) == 0x7F80) f |= 4u; if ((O[i] & 0x7F80) == 0x7F80) f |= 8u; }
    if (f) atomicOr(flag, f);
}
template <int MODE>
__device__ __forceinline__ void ln_phase(const Params& p, LAS unsigned char* lds, int layer, int which, const bf16_t* mix, bool final, bool use_mix = true, unsigned char* h8 = nullptr, bool dry = false, bool mix8 = false, bool wgrows = false) {
    LAUNDER_IDS();
    unsigned char* ws = p.ws; bf16_t* h = (bf16_t*)(ws + WS_H); bf16_t* hout = dry ? (bf16_t*)(ws + WS_BIG + 5 * ACT1 + ACT1) : h;
    const int lane = TIDX & 63, wave = TIDX >> 6;
    const float* gp = p.in[3] + (size_t)(layer * 3 + which) * 1024; const float* bp = p.in[4] + (size_t)(layer * 3 + which) * 1024;
    const int c0 = lane * 8, c1 = 512 + lane * 8;
    f32x4 gv[4], bv[4];
    gv[0] = *(const f32x4*)(gp + c0); gv[1] = *(const f32x4*)(gp + c0 + 4); gv[2] = *(const f32x4*)(gp + c1); gv[3] = *(const f32x4*)(gp + c1 + 4);
    bv[0] = *(const f32x4*)(bp + c0); bv[1] = *(const f32x4*)(bp + c0 + 4); bv[2] = *(const f32x4*)(bp + c1); bv[3] = *(const f32x4*)(bp + c1 + 4);
    const int* tslot = (const int*)(ws + WS_TSLOT); const float* gates = (const float*)(ws + WS_GATE); const LAS int* mi_ = (const LAS int*)(lds + MISC_OFF + 64);
    const int stride = wgrows ? 8 : GDIMX * 8, row0 = wgrows ? BIDX * 256 + wave : BIDX * 8 + wave, rend = wgrows ? BIDX * 256 + 256 : MT;
    constexpr int NM = MODE == 0 ? 1 : 4;
    u32x4 nh0, nh1, nm0[NM], nm1[NM], nb0[NM], nb1[NM]; const bf16_t* b2h = (const bf16_t*)(ws + WS_B2H) + (size_t)layer * 32 * 1024; int4 ncode = make_int4(0, 0, 0, 0); f32x4 ngate = {0.f, 0.f, 0.f, 0.f}, cgate = {0.f, 0.f, 0.f, 0.f};
#define LN_SLOTS(code_, out_) do { out_[0] = mi_[1 + ((unsigned)code_.x >> 24)] * 256 + (code_.x & 0xffffff); out_[1] = mi_[1 + ((unsigned)code_.y >> 24)] * 256 + (code_.y & 0xffffff); \
        out_[2] = mi_[1 + ((unsigned)code_.z >> 24)] * 256 + (code_.z & 0xffffff); out_[3] = mi_[1 + ((unsigned)code_.w >> 24)] * 256 + (code_.w & 0xffffff); } while (0)
#define LN_FETCH(r_, code_) do { const int rr_ = (r_) < rend ? (r_) : row0; nh0 = *(const u32x4*)(h + (size_t)rr_ * 1024 + c0); nh1 = *(const u32x4*)(h + (size_t)rr_ * 1024 + c1); \
        if (MODE == 0) { if (mix8) { const u32x2 y0_ = *(const u32x2*)((const unsigned char*)mix + (size_t)rr_ * 1024 + c0), y1_ = *(const u32x2*)((const unsigned char*)mix + (size_t)rr_ * 1024 + c1); \
                nm0[0] = (u32x4){y0_.x, y0_.y, 0u, 0u}; nm1[0] = (u32x4){y1_.x, y1_.y, 0u, 0u}; } \
            else { nm0[0] = *(const u32x4*)(mix + (size_t)rr_ * 1024 + c0); nm1[0] = *(const u32x4*)(mix + (size_t)rr_ * 1024 + c1); } } \
        else { int sl_[4]; LN_SLOTS(code_, sl_); const int ex_[4] = {(int)((unsigned)code_.x >> 24), (int)((unsigned)code_.y >> 24), (int)((unsigned)code_.z >> 24), (int)((unsigned)code_.w >> 24)}; \
            _Pragma("unroll") for (int k = 0; k < NM; ++k) { const u32x2 y0_ = *(const u32x2*)((const unsigned char*)mix + (size_t)sl_[k] * 1024 + c0), y1_ = *(const u32x2*)((const unsigned char*)mix + (size_t)sl_[k] * 1024 + c1); \
                nm0[k] = (u32x4){y0_.x, y0_.y, 0u, 0u}; nm1[k] = (u32x4){y1_.x, y1_.y, 0u, 0u};     \
                nb0[k] = *(const u32x4*)(b2h + (size_t)ex_[k] * 1024 + c0); nb1[k] = *(const u32x4*)(b2h + (size_t)ex_[k] * 1024 + c1); } } } while (0)
    if (MODE == 1) { ncode = *(const int4*)(tslot + (size_t)row0 * 4); ngate = *(const f32x4*)(gates + (size_t)row0 * 4); }
    LN_FETCH(row0, ncode);
    if (MODE == 1) { cgate = ngate; const int r2 = row0 + stride < rend ? row0 + stride : row0; ncode = *(const int4*)(tslot + (size_t)r2 * 4); ngate = *(const f32x4*)(gates + (size_t)r2 * 4); }
    const unsigned dmy0 = ((const unsigned short*)gp)[lane], dmy1 = ((const unsigned short*)bp)[lane];
    for (int row = row0; row < rend; row += stride) {
        const u32x4 h0 = nh0, h1 = nh1; u32x4 m0[NM], m1[NM], q0[NM], q1[NM];
#pragma unroll
        for (int k = 0; k < NM; ++k) { m0[k] = nm0[k]; m1[k] = nm1[k]; if (MODE == 1) { q0[k] = nb0[k]; q1[k] = nb1[k]; } }
        const f32x4 gt = cgate;
        LN_FETCH(row + stride, ncode);
        if (MODE == 1) { cgate = ngate; const int r2 = row + 2 * stride < rend ? row + 2 * stride : row0; ncode = *(const int4*)(tslot + (size_t)r2 * 4); ngate = *(const f32x4*)(gates + (size_t)r2 * 4); }
        float v[16];
#pragma unroll
        for (int i = 0; i < 4; ++i) { v[2 * i] = ALPHA * lo16(h0[i]); v[2 * i + 1] = ALPHA * hi16(h0[i]); v[8 + 2 * i] = ALPHA * lo16(h1[i]); v[8 + 2 * i + 1] = ALPHA * hi16(h1[i]); }
        if (MODE == 0) { if (use_mix) {
#pragma unroll
            for (int i = 0; i < 4; ++i) {
                if (mix8) { const f32x2 ya = (i & 1) ? fp8x2_hi(m0[0][i >> 1]) : fp8x2_lo(m0[0][i >> 1]), yb = (i & 1) ? fp8x2_hi(m1[0][i >> 1]) : fp8x2_lo(m1[0][i >> 1]);
                    v[2 * i] += ya.x; v[2 * i + 1] += ya.y; v[8 + 2 * i] += yb.x; v[8 + 2 * i + 1] += yb.y; }
                else { v[2 * i] += lo16(m0[0][i]); v[2 * i + 1] += hi16(m0[0][i]); v[8 + 2 * i] += lo16(m1[0][i]); v[8 + 2 * i + 1] += hi16(m1[0][i]); } } }
        } else if (!DBG_NO_MOE) {
#pragma unroll
            for (int k = 0; k < NM; ++k) { const float gk = gt[k];
#pragma unroll
                for (int i = 0; i < 4; ++i) { const f32x2 ya = (i & 1) ? fp8x2_hi(m0[k][i >> 1]) : fp8x2_lo(m0[k][i >> 1]), yb = (i & 1) ? fp8x2_hi(m1[k][i >> 1]) : fp8x2_lo(m1[k][i >> 1]);
                    v[2 * i] += gk * (ya.x + lo16(q0[k][i])); v[2 * i + 1] += gk * (ya.y + hi16(q0[k][i]));
                    v[8 + 2 * i] += gk * (yb.x + lo16(q1[k][i])); v[8 + 2 * i + 1] += gk * (yb.y + hi16(q1[k][i])); } }
        }
        float s = 0.f;
#pragma unroll
        for (int i = 0; i < 16; ++i) s += v[i];
#pragma unroll
        for (int o = 32; o >= 1; o >>= 1) s += __shfl_xor(s, o);
        const float mean = s * (1.0f / 1024.0f); float q = 0.f;
#pragma unroll
        for (int i = 0; i < 16; ++i) { v[i] -= mean; q += v[i] * v[i]; }
#pragma unroll
        for (int o = 32; o >= 1; o >>= 1) q += __shfl_xor(q, o);
        const float rstd = rsqrtf(q * (1.0f / 1024.0f) + LN_EPS);
#pragma unroll
        for (int i = 0; i < 4; ++i)
#pragma unroll
            for (int e = 0; e < 4; ++e) v[4 * i + e] = v[4 * i + e] * rstd * gv[i][e] + bv[i][e];
        u32x4 w0, w1; w0.x = pk2(v[0], v[1]); w0.y = pk2(v[2], v[3]); w0.z = pk2(v[4], v[5]); w0.w = pk2(v[6], v[7]);
        w1.x = pk2(v[8], v[9]); w1.y = pk2(v[10], v[11]); w1.z = pk2(v[12], v[13]); w1.w = pk2(v[14], v[15]);
        *(u32x4*)(hout + (size_t)row * 1024 + c0) = w0; *(u32x4*)(hout + (size_t)row * 1024 + c1) = w1;
        if (h8) { u32x2 a, bq; a.x = pk4_fp8(v[0], v[1], v[2], v[3]); a.y = pk4_fp8(v[4], v[5], v[6], v[7]); bq.x = pk4_fp8(v[8], v[9], v[10], v[11]); bq.y = pk4_fp8(v[12], v[13], v[14], v[15]);
            *(u32x2*)(h8 + (size_t)row * 1024 + c0) = a; *(u32x2*)(h8 + (size_t)row * 1024 + c1) = bq; }
        if (final && !dry) { float* o = p.out + (size_t)row * 1024;
            *(f32x4*)(o + c0) = (f32x4){v[0], v[1], v[2], v[3]}; *(f32x4*)(o + c0 + 4) = (f32x4){v[4], v[5], v[6], v[7]};
            *(f32x4*)(o + c1) = (f32x4){v[8], v[9], v[10], v[11]}; *(f32x4*)(o + c1 + 4) = (f32x4){v[12], v[13], v[14], v[15]}; }
    }
    asm volatile("" :: "v"(dmy0), "v"(dmy1));
#undef LN_SLOTS
#undef LN_FETCH
}

template <int K> __device__ __forceinline__ float quad_bcast(float v) { return __int_as_float(__builtin_amdgcn_update_dpp(0, __float_as_int(v), K * 0x55, 0xf, 0xf, false)); }
constexpr int HG_QI = 0, HG_KI = 4352, HG_KIT = 8704  , HG_VT = 8704  , HG_EB0 = 16896, HG_EE = 17408, HG_BUF = 17920, HG_OB = 2 * HG_BUF, HG_OBSZ = 16 * 132 * 4, HG_VROW = 16;
__device__ __forceinline__ void hgrn_scan_phase(const Params& p, LAS unsigned char* lds, int j) {
    LAUNDER_IDS();
    unsigned char* ws = p.ws;
    const bf16_t* Qb = (const bf16_t*)(ws + WS_BIG + BA_Q); const bf16_t* E1b = (const bf16_t*)(ws + WS_BIG + BA_E1); const bf16_t* KIb = (const bf16_t*)(ws + WS_BIG + BA_KI);
    const bf16_t* VTb = (const bf16_t*)(ws + WS_BIG + BA_VT); const bf16_t* Gb = (const bf16_t*)(ws + WS_BIG + BA_G); const float* HGSb = (const float*)(ws + WS_HGS);
    bf16_t* T0 = (bf16_t*)(ws + WS_T0);
    const int tid = TIDX, lane = tid & 63, wave = __builtin_amdgcn_readfirstlane(tid >> 6), fr = lane & 15, fq = lane >> 4;
    const bool mfma_role = wave < 4;
    const int pt = tid & 255, ptok = pt >> 4, pc8 = (pt & 15) * 8;
    if (j == 0 && GDIMX > 128 && BIDX >= 128) {
        conv_group8(lds, p.in[25] + (size_t)96 * 1024 * 2048, ws + WS_W1 + (size_t)96 * 2048 * 1024, 32, 2048, 2, 64.0f, BIDX - 128, GDIMX - 128);
        conv_group8(lds, p.in[27] + (size_t)96 * 1024 * 1024, ws + WS_W2 + (size_t)96 * 1024 * 1024, 32, 1024, 0, 64.0f, BIDX - 128, GDIMX - 128);
        return; }
    if (j == 0 && GDIMX <= 128) {
        conv_group8(lds, p.in[25] + (size_t)96 * 1024 * 2048, ws + WS_W1 + (size_t)96 * 2048 * 1024, 32, 2048, 2, 64.0f);
        conv_group8(lds, p.in[27] + (size_t)96 * 1024 * 1024, ws + WS_W2 + (size_t)96 * 1024 * 1024, 32, 1024, 0, 64.0f); }
    for (int unit = BIDX; unit < 128; unit += GDIMX) {
        const int b = unit >> 3, hd = unit & 7;
        const size_t base = (size_t)b * SEQ * 1024 + hd * 128;
        if (mfma_role) {
            f32x4 S[8][2];
#pragma unroll
            for (int i = 0; i < 8; ++i) { S[i][0] = (f32x4){0.f, 0.f, 0.f, 0.f}; S[i][1] = (f32x4){0.f, 0.f, 0.f, 0.f}; }
            __syncthreads();
            for (int step = 0; step < 256; ++step) {
                const int cb = step & 1; LAS unsigned char* hb = lds + cb * HG_BUF;
                const LAS bf16_t* qi = (const LAS bf16_t*)(hb + HG_QI); const LAS bf16_t* ki = (const LAS bf16_t*)(hb + HG_KI);
                const LAS bf16_t* vT = (const LAS bf16_t*)(hb + HG_VT);
                const LAS float* eb0 = (const LAS float*)(hb + HG_EB0); const LAS float* ee = (const LAS float*)(hb + HG_EE);
                LAS float* ob = (LAS float*)(lds + HG_OB + cb * HG_OBSZ);
                f32x4 at = {0.f, 0.f, 0.f, 0.f};
#pragma unroll
                for (int kk = 0; kk < 4; ++kk) { const bf16x8 kf = *(const LAS bf16x8*)(ki + fr * 136 + 32 * kk + 8 * fq), qf = *(const LAS bf16x8*)(qi + fr * 136 + 32 * kk + 8 * fq); at = mfma32(kf, qf, at); }
#pragma unroll
                for (int r = 0; r < 4; ++r) if (4 * fq + r > fr) at[r] = 0.f;
                const bf16x4 pa = mk4f(at);
                bf16x4 vf[2];
#pragma unroll
                for (int nt = 0; nt < 2; ++nt) vf[nt] = __builtin_amdgcn_ds_read_tr16_b64_v4i16((LAS bf16x4*)(vT + (4 * fq + (fr >> 2)) * 136 + 32 * wave + 16 * nt + 4 * (fr & 3)));
#pragma unroll
                for (int i = 0; i < 8; ++i) { const f32x4 e0 = *(const LAS f32x4*)(eb0 + 16 * i + 4 * fq); S[i][0] = S[i][0] * e0; S[i][1] = S[i][1] * e0; }
                f32x4 o[2];
#pragma unroll
                for (int nt = 0; nt < 2; ++nt) { o[nt] = (f32x4){0.f, 0.f, 0.f, 0.f}; o[nt] = mfma16(pa, vf[nt], o[nt]); }
#pragma unroll
                for (int kk = 0; kk < 4; ++kk) {
                    const u32x2 qa = *(const LAS u32x2*)(qi + fr * 136 + 32 * kk + 4 * fq), qb = *(const LAS u32x2*)(qi + fr * 136 + 32 * kk + 16 + 4 * fq);
                    const bf16x8 qp = mk8(qa, qb);
#pragma unroll
                    for (int nt = 0; nt < 2; ++nt) o[nt] = mfma32(qp, mk8f(S[2 * kk][nt], S[2 * kk + 1][nt]), o[nt]); }
#pragma unroll
                for (int nt = 0; nt < 2; ++nt)
#pragma unroll
                    for (int r = 0; r < 4; ++r) ob[(4 * fq + r) * 132 + 32 * wave + 16 * nt + fr] = o[nt][r];
#pragma unroll
                for (int i = 0; i < 8; ++i) { const bf16x4 kf = __builtin_amdgcn_ds_read_tr16_b64_v4i16((LAS bf16x4*)(ki + (4 * fq + (fr >> 2)) * 136 + 16 * i + 4 * (fr & 3)));
                    const f32x4 e1 = *(const LAS f32x4*)(ee + 16 * i + 4 * fq);
#pragma unroll
                    for (int nt = 0; nt < 2; ++nt) S[i][nt] = mfma16(kf, vf[nt], S[i][nt]) * e1; }
                __syncthreads();
            }
            __syncthreads();
        } else {
            __builtin_amdgcn_s_setprio(3);
            f32x4 ngv[2]; ngv[0] = *(const f32x4*)(p.in[7] + (size_t)j * 1024 + hd * 128 + pc8); ngv[1] = *(const f32x4*)(p.in[7] + (size_t)j * 1024 + hd * 128 + pc8 + 4);
            u32x4 pq[4], pe1[4], pki[4], pv[4], pg[4]; f32x4 psm[4];
#define HG_LOAD(slot_, step_) do { { const int st_ = (step_) < 256 ? (step_) : 255;     \
                const size_t o_ = base + (size_t)(st_ * 16 + ptok) * 1024 + pc8; \
                pq[slot_] = *(const u32x4*)(Qb + o_); pe1[slot_] = *(const u32x4*)(E1b + o_); pki[slot_] = *(const u32x4*)(KIb + o_); \
                pv[slot_] = *(const u32x4*)(VTb + o_); \
                psm[slot_] = *(const f32x4*)(HGSb + (size_t)(1 + ((pt >> 5) & 1)) * (HGS1 / 4) + (size_t)(b * 256 + st_) * 1024 + hd * 128 + (pt & 31) * 4); } } while (0)
#define HG_LOADG(slot_, step_) do { const int st_ = (step_) < 256 ? (step_) : 255; pg[slot_] = *(const u32x4*)(Gb + base + (size_t)(st_ * 16 + ptok) * 1024 + pc8); } while (0)
#define HG_STAGE1(B_, slot_) do { LAS unsigned char* hb_ = lds + (B_) * HG_BUF; u32x4 qiw_; \
                _Pragma("unroll") for (int e = 0; e < 4; ++e) qiw_[e] = pk2(lo16(pq[slot_][e]) * lo16(pe1[slot_][e]), hi16(pq[slot_][e]) * hi16(pe1[slot_][e])); \
                *(LAS u32x4*)(hb_ + HG_QI + (ptok * 136 + pc8) * 2) = qiw_; \
                *(LAS u32x4*)(hb_ + HG_KI + (ptok * 136 + pc8) * 2) = pki[slot_]; \
                *(LAS u32x4*)(hb_ + HG_VT + (ptok * 136 + pc8) * 2) = pv[slot_]; \
                *(LAS f32x4*)(hb_ + HG_EB0 + (pt & 63) * 16) = psm[slot_]; } while (0)
#define HG_STAGE3(step_, slot_) do { const LAS float* ob_ = (const LAS float*)(lds + HG_OB + ((step_) & 1) * HG_OBSZ); \
                const f32x4 x0_ = *(const LAS f32x4*)(ob_ + ptok * 132 + pc8), x1_ = *(const LAS f32x4*)(ob_ + ptok * 132 + pc8 + 4); \
                float ss_ = (x0_[0] * x0_[0] + x0_[1] * x0_[1]) + (x0_[2] * x0_[2] + x0_[3] * x0_[3]) + (x1_[0] * x1_[0] + x1_[1] * x1_[1]) + (x1_[2] * x1_[2] + x1_[3] * x1_[3]); \
                ss_ += __int_as_float(__builtin_amdgcn_update_dpp(0, __float_as_int(ss_), 0x128, 0xf, 0xf, false)); \
                ss_ += __int_as_float(__builtin_amdgcn_update_dpp(0, __float_as_int(ss_), 0x124, 0xf, 0xf, false)); \
                ss_ += __int_as_float(__builtin_amdgcn_update_dpp(0, __float_as_int(ss_), 0x122, 0xf, 0xf, false)); \
                ss_ += __int_as_float(__builtin_amdgcn_update_dpp(0, __float_as_int(ss_), 0x121, 0xf, 0xf, false)); \
                const float rr_ = rsqrtf(ss_ * (1.0f / 128.0f) + LN_EPS); const u32x4 gw_ = pg[slot_]; u32x4 w_; \
                w_.x = pk2(x0_[0] * rr_ * ngv[0][0] * lo16(gw_.x), x0_[1] * rr_ * ngv[0][1] * hi16(gw_.x)); w_.y = pk2(x0_[2] * rr_ * ngv[0][2] * lo16(gw_.y), x0_[3] * rr_ * ngv[0][3] * hi16(gw_.y)); \
                w_.z = pk2(x1_[0] * rr_ * ngv[1][0] * lo16(gw_.z), x1_[1] * rr_ * ngv[1][1] * hi16(gw_.z)); w_.w = pk2(x1_[2] * rr_ * ngv[1][2] * lo16(gw_.w), x1_[3] * rr_ * ngv[1][3] * hi16(gw_.w)); \
                if (FP8_MIXOUT) { u32x2 w8_; w8_.x = pk4_fp8(lo16(w_.x), hi16(w_.x), lo16(w_.y), hi16(w_.y)); w8_.y = pk4_fp8(lo16(w_.z), hi16(w_.z), lo16(w_.w), hi16(w_.w)); \
                    *(u32x2*)((unsigned char*)T0 + base + (size_t)((step_) * 16 + ptok) * 1024 + pc8) = w8_; } \
                else *(u32x4*)(T0 + base + (size_t)((step_) * 16 + ptok) * 1024 + pc8) = w_; } while (0)
#define HG_PBODY(step_, U_) do { \
                if ((step_) + 1 < 256) HG_STAGE1(((U_) + 1) & 1, ((U_) + 1) & 3); \
                HG_LOAD(((U_) + 1) & 3, (step_) + 5); \
                if ((step_) > 0) HG_STAGE3((step_) - 1, ((U_) + 3) & 3); \
                HG_LOADG(((U_) + 3) & 3, (step_) + 3); \
                __syncthreads(); } while (0)
            HG_LOAD(0, 0); HG_LOAD(1, 1); HG_LOAD(2, 2); HG_LOAD(3, 3);
            HG_LOADG(0, 0); HG_LOADG(1, 1); HG_LOADG(2, 2);
            HG_STAGE1(0, 0);
            HG_LOAD(0, 4);
            __syncthreads();
            for (int s4 = 0; s4 < 256; s4 += 4) { HG_PBODY(s4, 0); HG_PBODY(s4 + 1, 1); HG_PBODY(s4 + 2, 2); HG_PBODY(s4 + 3, 3); }
            HG_STAGE3(255, 3);
            __syncthreads();
            __builtin_amdgcn_s_setprio(0);
#undef HG_LOAD
#undef HG_LOADG
#undef HG_STAGE1
#undef HG_STAGE3
#undef HG_PBODY
        }
    }
}

__device__ __forceinline__ void s5_phase(const Params& p, LAS unsigned char* lds) {
    LAUNDER_IDS();
    unsigned char* ws = p.ws;
    const int tid = TIDX, lane = tid & 63, wave = tid >> 6, fr = lane & 15, fq = lane >> 4;
    if (wave >= 4) return;
    const bf16_t* h = (const bf16_t*)(ws + WS_H); bf16_t* T0 = (bf16_t*)(ws + WS_T0);
    LAS float* BU = (LAS float*)(lds + wave * 16384);
    LAS bf16_t* X = (LAS bf16_t*)(lds + wave * 16384 + 8448);
    for (int task = BIDX * 4 + wave; task < 1024; task += GDIMX * 4) {
        int b = task >> 6, g = task & 63;
        if (GDIMX == 256) { const int xq = BIDX & 7, yq = BIDX >> 3; b = 2 * xq + (yq >> 4); g = (yq & 15) * 4 + wave; }
        const float* lam = (const float*)(ws + WS_S5LAM) + (size_t)(g * 64 + lane) * 2; const float lr = lam[0], li = lam[1];
        bf16x8 bf[8], cf[4];
        const bf16x8 zero8 = {0, 0, 0, 0, 0, 0, 0, 0};
#pragma unroll
        for (int t = 0; t < 8; ++t) bf[t] = fq < 2 ? *(const bf16x8*)((const bf16_t*)(ws + WS_S5BT) + (size_t)(g * 128 + 16 * t + fr) * 16 + 8 * fq) : zero8;
#pragma unroll
        for (int kk = 0; kk < 4; ++kk) cf[kk] = *(const bf16x8*)((const bf16_t*)(ws + WS_S5C) + (size_t)(g * 16 + fr) * 128 + 32 * kk + 8 * fq);
        float dsk[4];
#pragma unroll
        for (int r = 0; r < 4; ++r) dsk[r] = p.in[18][g * 16 + 4 * fq + r];
        f32x2 xv = {0.f, 0.f}; const f32x2 cl = {lr, lr}, cn = {-li, li};
        const size_t base = (size_t)b * SEQ * 1024 + g * 16;
        u32x4 nu = *(const u32x4*)(h + base + (size_t)fr * 1024 + 8 * (fq & 1));
        u32x2 ns = *(const u32x2*)(h + base + (size_t)fr * 1024 + 4 * fq);
        const unsigned dmy = h[base + 16 + fr];
        for (int tb = 0; tb < 256; ++tb) {
            asm volatile("" : "+v"(nu), "+v"(ns));
            const bf16x8 cu = fq >= 2 ? zero8 : __builtin_bit_cast(bf16x8, nu); const u32x2 cs = ns;
            { const size_t nb_ = base + (size_t)(tb + 1 < 256 ? tb + 1 : 255) * 16 * 1024;
                nu = *(const u32x4*)(h + nb_ + (size_t)fr * 1024 + 8 * (fq & 1));
                ns = *(const u32x2*)(h + nb_ + (size_t)fr * 1024 + 4 * fq); }
#pragma unroll
            for (int t = 0; t < 8; ++t) { f32x4 a = {0.f, 0.f, 0.f, 0.f}; a = mfma32(cu, bf[t], a);
#pragma unroll
                for (int r = 0; r < 4; ++r) BU[(4 * fq + r) * 132 + 16 * t + fr] = a[r]; }
            asm volatile("s_waitcnt lgkmcnt(0)" ::: "memory"); __builtin_amdgcn_wave_barrier();
            { f32x2 bb[16];
#pragma unroll
                for (int t = 0; t < 16; ++t) { bb[t].x = BU[t * 132 + lane]; bb[t].y = BU[t * 132 + 64 + lane]; }
                asm volatile("" : "+v"(bb[0]), "+v"(bb[1]), "+v"(bb[2]), "+v"(bb[3]), "+v"(bb[4]), "+v"(bb[5]), "+v"(bb[6]), "+v"(bb[7]), "+v"(bb[8]), "+v"(bb[9]), "+v"(bb[10]), "+v"(bb[11]), "+v"(bb[12]), "+v"(bb[13]), "+v"(bb[14]), "+v"(bb[15]));
                f32x2 xa[16];
#pragma unroll
                for (int t = 0; t < 16; ++t) {
                    const f32x2 tt = __builtin_elementwise_fma(cn, xv.yx, bb[t]);
                    xv = __builtin_elementwise_fma(cl, xv, tt); xa[t] = xv; }
#pragma unroll
                for (int t = 0; t < 16; t += 2) {
                    const unsigned pr = pk2(xa[t].x, xa[t + 1].x), pi = pk2(xa[t].y, xa[t + 1].y);
                    X[t * 136 + lane] = (bf16_t)(pr & 0xffffu); X[(t + 1) * 136 + lane] = (bf16_t)(pr >> 16);
                    X[t * 136 + 64 + lane] = (bf16_t)(pi & 0xffffu); X[(t + 1) * 136 + 64 + lane] = (bf16_t)(pi >> 16); } }
            asm volatile("s_waitcnt lgkmcnt(0)" ::: "memory"); __builtin_amdgcn_wave_barrier();
            f32x4 acc = {0.f, 0.f, 0.f, 0.f};
#pragma unroll
            for (int kk = 0; kk < 4; ++kk) { const bf16x8 xf = *(const LAS bf16x8*)(X + fr * 136 + 32 * kk + 8 * fq); acc = mfma32(cf[kk], xf, acc); }
            { static_assert(FP8_GLU, "the S5 mixer output is stored as e4m3");
                const float y0 = acc[0] + dsk[0] * lo16(cs.x), y1 = acc[1] + dsk[1] * hi16(cs.x), y2 = acc[2] + dsk[2] * lo16(cs.y), y3 = acc[3] + dsk[3] * hi16(cs.y);
                *(unsigned*)((unsigned char*)T0 + base + (size_t)(tb * 16 + fr) * 1024 + 4 * fq) = pk4_fp8(gelu_tanh(y0), gelu_tanh(y1), gelu_tanh(y2), gelu_tanh(y3)); }
            asm volatile("s_waitcnt lgkmcnt(0)" ::: "memory"); __builtin_amdgcn_wave_barrier();
        }
        asm volatile("" :: "v"(dmy));
    }
}

constexpr int DK_ROW = 72, DV_ROW = 136, DK_SLOT = 128 * DK_ROW * 2, DV_SLOT = 64 * DV_ROW * 2, DV_OFF = 3 * DK_SLOT;
__device__ __forceinline__ void dl_desc(int i, int& g, int& dl, int& r, int& n) {
    if (i < 32) { g = 0; dl = 1; r = 0; n = i; } else if (i < 64) { g = 1; dl = 4; r = (i - 32) >> 3; n = (i - 32) & 7; } else { g = 2; dl = 16; r = (i - 64) >> 1; n = (i - 64) & 1; } }
__device__ __forceinline__ void dilated_bh(const bf16_t* proj, bf16_t* og, float* lse, LAS unsigned char* lds, int tid, int b, int head) {
    const int lane = tid & 63, wave = tid >> 6, fr = lane & 15, fq = lane >> 4;
    const size_t tok0 = (size_t)b * SEQ;
    const int srow = tid >> 3, sc = tid & 7;
    const int vk = (tid >> 3) * 2, vc = tid & 7;
    const int vrow = 32 * (vc & 1) + 4 * (vc >> 1);
    const int qi_ = 16 * wave + fr;
    u32x2 fk0[3], fk1[3], fv0[3], fv1[3], fq0[3], fq1[3];
    const unsigned char* proj8 = (const unsigned char*)proj;
#define DL_FETCH(u_, i_) do { int g_, dl_, r_, n_; dl_desc((i_) < 96 ? (i_) : 95, g_, dl_, r_, n_);     \
        const size_t t0_ = tok0 + ((size_t)n_ * 128) * dl_ + r_; const size_t qc_ = (size_t)g_ * 3072 + head * 64; \
        fk0[u_] = *(const u32x2*)(proj8 + (t0_ + (size_t)srow * dl_) * 9216 + qc_ + 1024 + sc * 8); fk1[u_] = *(const u32x2*)(proj8 + (t0_ + (size_t)(srow + 64) * dl_) * 9216 + qc_ + 1024 + sc * 8); \
        fv0[u_] = *(const u32x2*)(proj8 + (t0_ + (size_t)vk * dl_) * 9216 + qc_ + 2048 + vc * 8); fv1[u_] = *(const u32x2*)(proj8 + (t0_ + (size_t)(vk + 1) * dl_) * 9216 + qc_ + 2048 + vc * 8); \
        const size_t qt_ = t0_ + (size_t)qi_ * dl_; fq0[u_] = *(const u32x2*)(proj8 + qt_ * 9216 + qc_ + 8 * fq); fq1[u_] = *(const u32x2*)(proj8 + qt_ * 9216 + qc_ + 32 + 8 * fq); } while (0)
#define DL_STORE(u_) do { LAS unsigned char* ks_ = lds + (u_) * DK_SLOT; LAS unsigned char* vs_ = lds + DV_OFF + (u_) * DV_SLOT;     \
        const u32x4 rk0 = f8x8_to_bf16x8(fk0[u_]), rk1 = f8x8_to_bf16x8(fk1[u_]), rv0 = f8x8_to_bf16x8(fv0[u_]), rv1 = f8x8_to_bf16x8(fv1[u_]); \
        *(LAS u32x4*)(ks_ + (srow * DK_ROW + sc * 8) * 2) = rk0; *(LAS u32x4*)(ks_ + ((srow + 64) * DK_ROW + sc * 8) * 2) = rk1; \
        _Pragma("unroll") for (int e = 0; e < 4; ++e) { \
            *(LAS unsigned*)(vs_ + ((vrow + 16 * (e >> 1) + 2 * (e & 1)) * DV_ROW + vk) * 2) = (rv0[e] & 0xffffu) | (rv1[e] << 16); \
            *(LAS unsigned*)(vs_ + ((vrow + 16 * (e >> 1) + 2 * (e & 1) + 1) * DV_ROW + vk) * 2) = (rv0[e] >> 16) | (rv1[e] & 0xffff0000u); } } while (0)
    __syncthreads();
    DL_FETCH(0, 0); DL_FETCH(1, 1); DL_FETCH(2, 2);
    DL_STORE(0);
    __syncthreads();
    for (int i3 = 0; i3 < 96; i3 += 3) {
#pragma unroll
        for (int u = 0; u < 3; ++u) {
            const int i = i3 + u; int g, dl, r, n; dl_desc(i, g, dl, r, n);
            bf16x8 qf[2]; qf[0] = __builtin_bit_cast(bf16x8, f8x8_to_bf16x8(fq0[u])); qf[1] = __builtin_bit_cast(bf16x8, f8x8_to_bf16x8(fq1[u]));
            DL_FETCH(u, i + 3);
            const int cs = u, ps = n == 0 ? cs : (u + 2) % 3;
            const size_t qtok = tok0 + (size_t)(n * 128 + qi_) * dl + r;
            f32x4 st[10]; float mx = -3.0e38f;
#pragma unroll
            for (int k = 0; k < 9; ++k) { int t = wave + k; const bool tok = t <= 15 && (n > 0 || t >= 8); t = t > 15 ? 15 : t;
                const LAS unsigned char* kb = lds + ((t < 8) ? ps : cs) * DK_SLOT + ((t & 7) * 16 + fr) * (DK_ROW * 2) + fq * 16;
                f32x4 a = {0.f, 0.f, 0.f, 0.f};
#pragma unroll
                for (int kk = 0; kk < 2; ++kk) a = mfma32(*(const LAS bf16x8*)(kb + kk * 64), qf[kk], a);
#pragma unroll
                for (int e = 0; e < 4; ++e) { const bool valid = tok && (k == 0 ? 4 * fq + e >= fr : (k == 8 ? 4 * fq + e <= fr : true));
                    a[e] = valid ? a[e] : -1.0e30f; mx = fmaxf(mx, a[e]); }
                st[k] = a; }
            mx = fmaxf(mx, __shfl_xor(mx, 16)); mx = fmaxf(mx, __shfl_xor(mx, 32));
            float sum = 0.f; const float esc = 0.125f * 1.4426950408889634f, eoff = -mx * esc;
#pragma unroll
            for (int k = 0; k < 9; ++k)
#pragma unroll
                for (int e = 0; e < 4; ++e) { const float pe = __builtin_amdgcn_exp2f(__builtin_fmaf(st[k][e], esc, eoff)); st[k][e] = pe; sum += pe; }
            st[9] = (f32x4){0.f, 0.f, 0.f, 0.f};
            sum += __shfl_xor(sum, 16); sum += __shfl_xor(sum, 32);
            f32x4 ot[4];
#pragma unroll
            for (int dt = 0; dt < 4; ++dt) ot[dt] = (f32x4){0.f, 0.f, 0.f, 0.f};
#pragma unroll
            for (int kk = 0; kk < 5; ++kk) { const bf16x8 pf = mk8f(st[2 * kk], st[2 * kk + 1]);
                int ta = wave + 2 * kk, tb = ta + 1; ta = ta > 15 ? 15 : ta; tb = tb > 15 ? 15 : tb;
                const LAS unsigned char* va_ = lds + DV_OFF + ((ta < 8) ? ps : cs) * DV_SLOT + (fr * DV_ROW + (ta & 7) * 16 + 4 * fq) * 2;
                const LAS unsigned char* vb_ = lds + DV_OFF + ((tb < 8) ? ps : cs) * DV_SLOT + (fr * DV_ROW + (tb & 7) * 16 + 4 * fq) * 2;
#pragma unroll
                for (int dt = 0; dt < 4; ++dt) { const u32x2 va = *(const LAS u32x2*)(va_ + dt * 16 * DV_ROW * 2), vb = *(const LAS u32x2*)(vb_ + dt * 16 * DV_ROW * 2);
                    ot[dt] = mfma32(mk8(va, vb), pf, ot[dt]); } }
            const float inv = __builtin_amdgcn_rcpf(sum); u32x4 ow;
#pragma unroll
            for (int dt = 0; dt < 4; ++dt) ow[dt] = pk4_fp8(ot[dt][0] * inv, ot[dt][1] * inv, ot[dt][2] * inv, ot[dt][3] * inv);
            *(u32x4*)((unsigned char*)og + qtok * 3072 + g * 1024 + head * 64 + 16 * fq) = ow;
            lse[qtok * 48 + g * 16 + head] = mx * 0.125f + __logf(sum);
            if (i + 1 < 96) DL_STORE((u + 1) % 3);
            __syncthreads();
        }
    }
#undef DL_FETCH
#undef DL_STORE
}
__device__ __forceinline__ void dilated_attn_phase(const Params& p, LAS unsigned char* lds) {
    LAUNDER_IDS();
    unsigned char* ws = p.ws;
    const bf16_t* proj = (const bf16_t*)(ws + WS_BIG + BB_PROJ); bf16_t* og = (bf16_t*)(ws + WS_BIG + BB_OG); float* lse = (float*)(ws + WS_LSE); bf16_t* T0 = (bf16_t*)(ws + WS_T0);
    const int tid = TIDX;
    for (int bh = BIDX; bh < 256; bh += GDIMX) {
        const int xq = bh & 7, yq = bh >> 3; const int b = GDIMX == 256 ? 2 * xq + (yq >> 4) : bh >> 4, head = GDIMX == 256 ? (yq & 15) : (bh & 15);
        dilated_bh(proj, og, lse, lds, tid, b, head);
        asm volatile("s_waitcnt vmcnt(0)" ::: "memory"); __syncthreads(); __builtin_amdgcn_fence(__ATOMIC_ACQUIRE, "agent"); asm volatile("s_waitcnt vmcnt(0)" ::: "memory");
        const int c8 = head * 64 + (tid & 7) * 8; const unsigned char* og8 = (const unsigned char*)og;
        for (int i0 = 0; i0 < 64; i0 += 4) {
            float l0[4], l1[4], l2[4]; u32x2 a[4], bq[4], c[4];
#pragma unroll
            for (int u = 0; u < 4; ++u) { const size_t tok = (size_t)b * SEQ + (i0 + u) * 64 + (tid >> 3);
                l0[u] = lse[tok * 48 + head]; l1[u] = lse[tok * 48 + 16 + head]; l2[u] = lse[tok * 48 + 32 + head];
                a[u] = *(const u32x2*)(og8 + tok * 3072 + c8); bq[u] = *(const u32x2*)(og8 + tok * 3072 + 1024 + c8); c[u] = *(const u32x2*)(og8 + tok * 3072 + 2048 + c8); }
#pragma unroll
            for (int u = 0; u < 4; ++u) { const size_t tok = (size_t)b * SEQ + (i0 + u) * 64 + (tid >> 3);
                const float m = fmaxf(l0[u], fmaxf(l1[u], l2[u])); float w0 = __expf(l0[u] - m), w1 = __expf(l1[u] - m), w2 = __expf(l2[u] - m); const float inv = __builtin_amdgcn_rcpf(w0 + w1 + w2); w0 *= inv; w1 *= inv; w2 *= inv;
                u32x4 w;
#pragma unroll
                for (int e = 0; e < 4; ++e) { const f32x2 fa = (e & 1) ? fp8x2_hi(a[u][e >> 1]) : fp8x2_lo(a[u][e >> 1]), fb = (e & 1) ? fp8x2_hi(bq[u][e >> 1]) : fp8x2_lo(bq[u][e >> 1]), fc = (e & 1) ? fp8x2_hi(c[u][e >> 1]) : fp8x2_lo(c[u][e >> 1]);
                    w[e] = pk2(w0 * fa.x + w1 * fb.x + w2 * fc.x, w0 * fa.y + w1 * fb.y + w2 * fc.y); }
                if (FP8_MIXOUT || FP8_DILOUT) { u32x2 w8; w8.x = pk4_fp8(lo16(w[0]), hi16(w[0]), lo16(w[1]), hi16(w[1])); w8.y = pk4_fp8(lo16(w[2]), hi16(w[2]), lo16(w[3]), hi16(w[3])); *(u32x2*)((unsigned char*)T0 + tok * 1024 + c8) = w8; }
                else *(u32x4*)(T0 + tok * 1024 + c8) = w; } }
    }
}

constexpr int XROW = 528;
__device__ __forceinline__ void cross_stage(LAS unsigned char* lds, const bf16_t* src, unsigned row_stride_bytes, int tid) {
    const unsigned goff = (unsigned)(tid >> 5) * row_stride_bytes + (unsigned)(tid & 31) * 16u;
    LAS unsigned char* dst = lds + (tid >> 5) * XROW + (tid & 31) * 16;
#pragma unroll
    for (int h = 0; h < 2; ++h) { u32x4 v[8];
#pragma unroll
        for (int i = 0; i < 8; ++i) v[i] = *(const u32x4*)((const unsigned char*)src + (size_t)(h * 8 + i) * 16 * row_stride_bytes + goff);
#pragma unroll
        for (int i = 0; i < 8; ++i) *(LAS u32x4*)(dst + (h * 8 + i) * 16 * XROW) = v[i]; }
}
__device__ __forceinline__ void cross_attn_phase(const Params& p, LAS unsigned char* lds) {
    LAUNDER_IDS();
    unsigned char* ws = p.ws;
    const bf16_t* qm = (const bf16_t*)(ws + WS_T0); const bf16_t* Km = (const bf16_t*)(ws + WS_KMEM); const bf16_t* VT = (const bf16_t*)(ws + WS_VTMEM); bf16_t* O = (bf16_t*)(ws + WS_T1);
    const int tid = TIDX, lane = tid & 63, wave = tid >> 6, fr = lane & 15, fq = lane >> 4;
    LAS unsigned char* kbase = lds + fr * XROW + fq * 16;
    LAS unsigned char* vbase = lds + fr * XROW + fq * 8;
    for (int unit = BIDX; unit < 16 * 4 * 16; unit += GDIMX) {
        int qt = unit & 15, head = (unit >> 4) & 3, b = unit >> 6;
        if (GDIMX == 256) { const int xq = BIDX & 7, yq = BIDX >> 3, gi = (unit >> 8) * 16 + xq * 2 + (yq >> 4); qt = yq & 15; head = gi & 3; b = gi >> 2; }
        const size_t tokq = (size_t)b * SEQ + qt * 256 + 32 * wave + fr;
        __syncthreads();
        cross_stage(lds, Km + (size_t)(b * 256) * 1024 + head * 256, 2048u, tid);
        const unsigned char* qm8 = (const unsigned char*)qm;
        bf16x8 qf[8];
#pragma unroll
        for (int kk = 0; kk < 8; ++kk) qf[kk] = __builtin_bit_cast(bf16x8, f8x8_to_bf16x8(*(const u32x2*)(qm8 + tokq * 1024 + head * 256 + 32 * kk + 8 * fq)));
        __syncthreads();
        bf16x8 pf[2][8];
#pragma unroll
        for (int g = 0; g < 2; ++g) {
            f32x4 st[16]; float mx = -3.0e38f;
            bf16x8 kf[2][8];
#pragma unroll
            for (int kk = 0; kk < 8; ++kk) kf[0][kk] = *(const LAS bf16x8*)(kbase + kk * 64);
            __builtin_amdgcn_sched_barrier(0);
#pragma unroll
            for (int t = 0; t < 16; ++t) { f32x4 a = {0.f, 0.f, 0.f, 0.f};
                if (t + 1 < 16) {
#pragma unroll
                    for (int kk = 0; kk < 8; ++kk) kf[(t + 1) & 1][kk] = *(const LAS bf16x8*)(kbase + (t + 1) * (16 * XROW) + kk * 64); }
#pragma unroll
                for (int kk = 0; kk < 8; ++kk) a = mfma32(kf[t & 1][kk], qf[kk], a);
#pragma unroll
                for (int e = 0; e < 4; ++e) mx = fmaxf(mx, a[e]);
                st[t] = a;
                __builtin_amdgcn_sched_barrier(0); }
            if (g == 0) {
#pragma unroll
                for (int kk = 0; kk < 8; ++kk) qf[kk] = __builtin_bit_cast(bf16x8, f8x8_to_bf16x8(*(const u32x2*)(qm8 + (tokq + 16) * 1024 + head * 256 + 32 * kk + 8 * fq))); }
            mx = fmaxf(mx, __shfl_xor(mx, 16)); mx = fmaxf(mx, __shfl_xor(mx, 32));
            float sum = 0.f; const float esc = 0.0625f * 1.4426950408889634f, eoff = -mx * esc;
#pragma unroll
            for (int t = 0; t < 16; ++t)
#pragma unroll
                for (int e = 0; e < 4; ++e) { const float pe = __builtin_amdgcn_exp2f(__builtin_fmaf(st[t][e], esc, eoff)); st[t][e] = pe; sum += pe; }
            sum += __shfl_xor(sum, 16); sum += __shfl_xor(sum, 32);
            const float inv = __builtin_amdgcn_rcpf(sum);
#pragma unroll
            for (int kk = 0; kk < 8; ++kk) pf[g][kk] = mk8f(st[2 * kk] * inv, st[2 * kk + 1] * inv);
        }
        __syncthreads();
        cross_stage(lds, VT + (size_t)(head * 256) * 4096 + b * 256, 8192u, tid);
        __syncthreads();
        u32x2 vfa[2][8], vfb[2][8];
        u32x4 ow0, ow1;
#pragma unroll
        for (int kk = 0; kk < 8; ++kk) { vfa[0][kk] = *(const LAS u32x2*)(vbase + kk * 64); vfb[0][kk] = *(const LAS u32x2*)(vbase + kk * 64 + 32); }
        __builtin_amdgcn_sched_barrier(0);
#pragma unroll
        for (int dt = 0; dt < 16; ++dt) { f32x4 o0 = {0.f, 0.f, 0.f, 0.f}, o1 = {0.f, 0.f, 0.f, 0.f};
            if (dt + 1 < 16) {
#pragma unroll
                for (int kk = 0; kk < 8; ++kk) { vfa[(dt + 1) & 1][kk] = *(const LAS u32x2*)(vbase + (dt + 1) * (16 * XROW) + kk * 64); vfb[(dt + 1) & 1][kk] = *(const LAS u32x2*)(vbase + (dt + 1) * (16 * XROW) + kk * 64 + 32); } }
#pragma unroll
            for (int kk = 0; kk < 8; ++kk) { const bf16x8 vf = mk8(vfa[dt & 1][kk], vfb[dt & 1][kk]); o0 = mfma32(vf, pf[0][kk], o0); o1 = mfma32(vf, pf[1][kk], o1); }
            __builtin_amdgcn_sched_barrier(0);
#if FP8_O
            ow0[dt & 3] = pk4_fp8(o0[0], o0[1], o0[2], o0[3]); ow1[dt & 3] = pk4_fp8(o1[0], o1[1], o1[2], o1[3]);
            if ((dt & 3) == 3) { *(u32x4*)((unsigned char*)O + tokq * 1024 + head * 256 + 64 * fq + 16 * (dt >> 2)) = ow0;
                *(u32x4*)((unsigned char*)O + (tokq + 16) * 1024 + head * 256 + 64 * fq + 16 * (dt >> 2)) = ow1; } }
#else
            static_assert(FP8_O, "the memory V^T rows are stored permuted for the e4m3 output path");
            u32x2 w; w.x = pk2(o0[0], o0[1]); w.y = pk2(o0[2], o0[3]); *(u32x2*)(O + tokq * 1024 + head * 256 + 16 * dt + 4 * fq) = w;
            w.x = pk2(o1[0], o1[1]); w.y = pk2(o1[2], o1[3]); *(u32x2*)(O + (tokq + 16) * 1024 + head * 256 + 16 * dt + 4 * fq) = w; }
#endif
    }
}

__device__ __forceinline__ void router_phase(const Params& p, LAS unsigned char* lds, int layer) {
    LAUNDER_IDS();
    unsigned char* ws = p.ws;
    const int tid = TIDX, lane = tid & 63, wave = tid >> 6;
    LAS unsigned* hist = (LAS unsigned*)(lds + MISC_OFF + 2048); LAS unsigned* basev = hist + 32;
    const bf16_t* h = (const bf16_t*)(ws + WS_H);
    const bf16_t* whi = (const bf16_t*)(ws + WS_WRHI) + (size_t)layer * 32 * 1024; const bf16_t* wlo = (const bf16_t*)(ws + WS_WRLO) + (size_t)layer * 32 * 1024;
    const float* rb = p.in[24] + layer * 32;
    int* tslot = (int*)(ws + WS_TSLOT); float* gates = (float*)(ws + WS_GATE); int* list = (int*)(ws + WS_LIST);
    unsigned* cnt = (unsigned*)(ws + CTL_CNT) + layer * 32;
    const int hs = lane >> 5, tl = lane & 31;
    for (int chunk = BIDX; chunk < MT / 256; chunk += GDIMX) {
        __syncthreads();
        if (tid < 32) hist[tid] = 0u;
        __syncthreads();
        const size_t tok = (size_t)chunk * 256 + wave * 32 + tl;
        const bf16_t* hp = h + tok * 1024 + 8 * hs; const bf16_t* ap = whi + (size_t)tl * 1024 + 8 * hs; const bf16_t* lp = wlo + (size_t)tl * 1024 + 8 * hs;
        f32x16 acc;
#pragma unroll
        for (int i = 0; i < 16; ++i) acc[i] = 0.f;
#pragma unroll 8
        for (int kk = 0; kk < 64; ++kk) { const bf16x8 bq = *(const bf16x8*)(hp + 16 * kk); const bf16x8 a1 = *(const bf16x8*)(ap + 16 * kk), a2 = *(const bf16x8*)(lp + 16 * kk);
            acc = __builtin_amdgcn_mfma_f32_32x32x16_bf16(a1, bq, acc, 0, 0, 0); acc = __builtin_amdgcn_mfma_f32_32x32x16_bf16(a2, bq, acc, 0, 0, 0); }
        float v[16];
#pragma unroll
        for (int i = 0; i < 16; ++i) v[i] = acc[i] + rb[(i & 3) + 8 * (i >> 2) + 4 * hs];
        float sv[4]; int si[4];
#pragma unroll
        for (int s = 0; s < 4; ++s) { float best = -3.0e38f; int bi = 99;
#pragma unroll
            for (int i = 0; i < 16; ++i) { const int id = (i & 3) + 8 * (i >> 2) + 4 * hs; if (v[i] > best || (v[i] == best && id < bi)) { best = v[i]; bi = id; } }
            sv[s] = best; si[s] = bi;
#pragma unroll
            for (int i = 0; i < 16; ++i) { const int id = (i & 3) + 8 * (i >> 2) + 4 * hs; if (id == bi) v[i] = -3.0e38f; } }
        float cv[8]; int ci[8];
#pragma unroll
        for (int s = 0; s < 4; ++s) { cv[s] = sv[s]; ci[s] = si[s]; cv[4 + s] = __shfl_xor(sv[s], 32); ci[4 + s] = __shfl_xor(si[s], 32); }
        float tv_[4]; int ti[4];
#pragma unroll
        for (int s = 0; s < 4; ++s) { float best = -3.0e38f; int bi = 99;
#pragma unroll
            for (int i = 0; i < 8; ++i) if (cv[i] > best || (cv[i] == best && ci[i] < bi)) { best = cv[i]; bi = ci[i]; }
            tv_[s] = best; ti[s] = bi & 31;
#pragma unroll
            for (int i = 0; i < 8; ++i) if (ci[i] == bi) cv[i] = -3.0e38f; }
        unsigned rk[4] = {0u, 0u, 0u, 0u};
        if (hs == 0) {
#pragma unroll
            for (int s = 0; s < 4; ++s) rk[s] = atomicAdd((unsigned*)&hist[ti[s]], 1u);
        }
        __syncthreads();
        if (tid < 32) { const unsigned hv = hist[tid]; basev[tid] = hv ? __hip_atomic_fetch_add(cnt + tid, hv, __ATOMIC_RELAXED, __HIP_MEMORY_SCOPE_AGENT) : 0u; }
        __syncthreads();
        if (hs == 0) {
            const float e1 = __expf(tv_[1] - tv_[0]), e2 = __expf(tv_[2] - tv_[0]), e3 = __expf(tv_[3] - tv_[0]); const float inv = 1.0f / (1.0f + e1 + e2 + e3);
            int code[4];
#pragma unroll
            for (int s = 0; s < 4; ++s) { unsigned idx = basev[ti[s]] + rk[s]; idx = idx < 65536u ? idx : 65535u; list[(size_t)ti[s] * 65536 + idx] = (int)tok; code[s] = (ti[s] << 24) | (int)idx; }
            *(int4*)(tslot + tok * 4) = make_int4(code[0], code[1], code[2], code[3]);
            *(f32x4*)(gates + tok * 4) = (f32x4){inv, e1 * inv, e2 * inv, e3 * inv};
        }
    }
}
__device__ __forceinline__ void moe_tables(const Params& p, LAS unsigned char* lds, int layer) {
    LAUNDER_IDS();
    LAS int* mi = (LAS int*)(lds + MISC_OFF + 64); LAS unsigned char* te = lds + MISC_OFF + 512;
    unsigned* cnt = (unsigned*)(p.ws + CTL_CNT) + layer * 32;
    __syncthreads();
    if (TIDX < 64) { const int e = TIDX & 31; unsigned c = __hip_atomic_load(cnt + e, __ATOMIC_RELAXED, __HIP_MEMORY_SCOPE_AGENT); c = c < 65536u ? c : 65536u;
        const int tiles = (int)((c + 255u) >> 8); int incl = tiles;
#pragma unroll
        for (int o = 1; o < 32; o <<= 1) { const int t = __shfl_up(incl, o, 32); if (e >= o) incl += t; }
        const int base = incl - tiles;
        if (TIDX < 32) { mi[1 + e] = base; mi[40 + e] = (int)c; if (e == 31) mi[0] = incl < NT_MAX ? incl : NT_MAX;
            for (int t = 0; t < tiles && base + t < NT_MAX; ++t) te[base + t] = (unsigned char)e; } }
    __syncthreads();
}

template <class Epi, bool FP8 = false>
__device__ __forceinline__ void gemm_std(LAS unsigned char* lds, const bf16_t* A, const bf16_t* Bt, int M, int N, int K, const Epi& E, int c_shift) {
    LAUNDER_IDS();
    pg8::Gemm g{A, Bt, M, N, K}; pg8::StaticOrder S; S.init(M, N, GDIMX, (BIDX + c_shift) % GDIMX);
    pg8::gemm_phase<Epi, pg8::StaticOrder, true, true, FP8>(lds, g, S, E);
}
constexpr int N_PHASES = 2 + (2 + 2 + 7) + (2 + 2 + 7) + (1 + 2 + 7) + (2 + 2 + 7);
__device__ __forceinline__ void wg_seam() { asm volatile("s_waitcnt vmcnt(0)" ::: "memory"); __syncthreads(); __builtin_amdgcn_fence(__ATOMIC_ACQUIRE, "agent"); asm volatile("s_waitcnt vmcnt(0)" ::: "memory"); }

__device__ __forceinline__ void grid_barrier(const XcdBarrier& b0) {
    XcdBarrier b = b0; unsigned long long a = (unsigned long long)b.bar; unsigned x = b.x;
    asm volatile("" : "+s"(a), "+s"(x)); b.bar = (unsigned*)a; b.x = x;
    xcd_barrier(b);
}
__device__ __forceinline__ LAS unsigned char* l_lds(LAS unsigned char* p) { unsigned a = (unsigned)(unsigned long long)p; asm volatile("" : "+s"(a)); return (LAS unsigned char*)(unsigned long long)a; }
typedef const __attribute__((address_space(4))) Params* KParams;
__device__ __forceinline__ Params load_params() {
    unsigned long long a = (unsigned long long)__builtin_amdgcn_kernarg_segment_ptr();
    asm volatile("" : "+s"(a));
    KParams P = (KParams)a; Params p;
#pragma unroll
    for (int i = 0; i < 29; ++i) p.in[i] = P->in[i];
    p.pos = P->pos; p.out = P->out; p.ws = P->ws; p.lo = P->lo; p.hi = P->hi; p.li = P->li; p.pad = 0;
    return p;
}
#define PHASE_FN static __device__ __forceinline__ void
#define KARGS() const Params p = load_params(); unsigned char* const ws = p.ws; (void)ws
PHASE_FN f_prologue(LAS unsigned char* lds) { KARGS(); prologue_phase(p, lds); }
PHASE_FN f_memkv(LAS unsigned char* lds) { KARGS();
    gemm_std(lds, (const bf16_t*)(ws + WS_MEMB), (const bf16_t*)(ws + WS_WKV), 4096, 1024, 1024, EpiPlain{(bf16_t*)(ws + WS_KMEM), 1024, 4, nullptr, 0}, 0);
    gemm_std(lds, (const bf16_t*)(ws + WS_WKV) + (size_t)1024 * 1024, (const bf16_t*)(ws + WS_MEMB), 1024, 4096, 1024, EpiPlain{(bf16_t*)(ws + WS_VTMEM), 4096, 16, nullptr, 0}, 128); }
PHASE_FN f_hgrn_in(LAS unsigned char* lds, int j) { KARGS();
#if FP8_HGRN
    gemm_std<EpiHgrn, true>(lds, (const bf16_t*)(ws + WS_H8), (const bf16_t*)(ws + WS_WAIN8 + (size_t)j * 4096 * 1024), MT, 3072, 512,
             EpiHgrn{ws + WS_BIG, (const float*)(ws + WS_LB) + j * 1024, (float*)(ws + WS_HGS), 0x320, lds + ROWIDX_OFF}, 0);
    gemm_std(lds, (const bf16_t*)(ws + WS_H), (const bf16_t*)(ws + WS_WAIN) + ((size_t)j * 4096 + 1024) * 1024, MT, 1024, 1024,
             EpiHgrn{ws + WS_BIG, (const float*)(ws + WS_LB) + j * 1024, (float*)(ws + WS_HGS), 0x1, lds + ROWIDX_OFF}, 0); }
#elif FP8_HGRN_QI
    gemm_std<EpiHgrn, true>(lds, (const bf16_t*)(ws + WS_H8), (const bf16_t*)(ws + WS_WAIN8 + (size_t)j * 4096 * 1024), MT, 2048, 512,
             EpiHgrn{ws + WS_BIG, (const float*)(ws + WS_LB) + j * 1024, (float*)(ws + WS_HGS), 0x20, lds + ROWIDX_OFF}, 0);
    gemm_std(lds, (const bf16_t*)(ws + WS_H), (const bf16_t*)(ws + WS_WAIN) + ((size_t)j * 4096 + 1024) * 1024, MT, 1024, 1024,
             EpiHgrn{ws + WS_BIG, (const float*)(ws + WS_LB) + j * 1024, (float*)(ws + WS_HGS), 0x1, lds + ROWIDX_OFF}, 0);
    gemm_std(lds, (const bf16_t*)(ws + WS_H), (const bf16_t*)(ws + WS_WAIN) + ((size_t)j * 4096 + 3072) * 1024, MT, 1024, 1024,
             EpiHgrn{ws + WS_BIG, (const float*)(ws + WS_LB) + j * 1024, (float*)(ws + WS_HGS), 0x3, lds + ROWIDX_OFF}, 0); }
#elif FP8_HGRN_G
    gemm_std(lds, (const bf16_t*)(ws + WS_H), (const bf16_t*)(ws + WS_WAIN) + (size_t)j * 4096 * 1024, MT, 3072, 1024,
             EpiHgrn{ws + WS_BIG, (const float*)(ws + WS_LB) + j * 1024, (float*)(ws + WS_HGS), 0x210, lds + ROWIDX_OFF}, 0);
    gemm_std<EpiHgrn, true>(lds, (const bf16_t*)(ws + WS_H8), (const bf16_t*)(ws + WS_WAIN8 + ((size_t)j * 4096 + 2048) * 1024), MT, 1024, 512,
             EpiHgrn{ws + WS_BIG, (const float*)(ws + WS_LB) + j * 1024, (float*)(ws + WS_HGS), 0x3, lds + ROWIDX_OFF}, 0); }
#else
    gemm_std(lds, (const bf16_t*)(ws + WS_H), (const bf16_t*)(ws + WS_WAIN) + (size_t)j * 4096 * 1024, MT, 4096, 1024,
             EpiHgrn{ws + WS_BIG, (const float*)(ws + WS_LB) + j * 1024, (float*)(ws + WS_HGS), 0x3210, lds + ROWIDX_OFF}, 0); }
#endif
PHASE_FN f_hgrn_in_light(LAS unsigned char* lds, int j) { KARGS();
    gemm_std(lds, (const bf16_t*)(ws + WS_H), (const bf16_t*)(ws + WS_WAIN) + (size_t)j * 4096 * 1024, MT, 4096, 1024, EpiPlain{(bf16_t*)(ws + WS_BIG + 6 * ACT1), 4096, 16, nullptr, 0}, 0); }
PHASE_FN f_hgrn_scan(LAS unsigned char* lds, int j) { KARGS();
    hgrn_scan_phase(p, lds, j);
}
PHASE_FN f_dil_in(LAS unsigned char* lds) { KARGS();
#if FP8_DIL
    gemm_std<EpiRope, true>(lds, (const bf16_t*)(ws + WS_H8), (const bf16_t*)(ws + WS_WBIN), MT, 9216, 512, EpiRope{(bf16_t*)(ws + WS_BIG + BB_PROJ), p.pos, (const float*)(ws + WS_ROPE)}, 0); }
#else
    gemm_std(lds, (const bf16_t*)(ws + WS_H), (const bf16_t*)(ws + WS_WBIN), MT, 9216, 1024, EpiRope{(bf16_t*)(ws + WS_BIG + BB_PROJ), p.pos, (const float*)(ws + WS_ROPE)}, 0); }
#endif
PHASE_FN f_dil_attn(LAS unsigned char* lds) { KARGS(); dilated_attn_phase(p, lds); }
PHASE_FN f_s5(LAS unsigned char* lds) { KARGS(); s5_phase(p, lds); }
PHASE_FN f_gemm_plain(LAS unsigned char* lds, int which, int layer) { KARGS();
    const int kind = layer % 3, j = layer / 3;
    bf16_t* O = (bf16_t*)(ws + (which == 1 ? WS_T0 : WS_MIX));
    const bool f8 = which == 0 ? (FP8_MIXOUT || (FP8_DILOUT && kind == 1)) : (which == 1 ? FP8_Q : FP8_O);
    const size_t wb = f8 ? 1 : 2;
    const unsigned char* A = ws + (which == 0 ? WS_T0 : (which == 1 ? (FP8_Q ? WS_H8 : WS_H) : WS_T1));
    const unsigned char* Bt = which == 0 ? (kind == 0 ? ws + WS_WAOUT + (size_t)j * 1024 * 1024 * wb : ws + WS_WBOUT) : ws + (which == 1 ? WS_WQ : WS_WO) + (size_t)layer * 1024 * 1024 * wb;
    if (which == 1) {
        if (f8) gemm_std<EpiPlainT<true>, true>(lds, (const bf16_t*)A, (const bf16_t*)Bt, MT, 1024, 512, EpiPlainT<true>{O, 1024, 4, nullptr, 0}, 0);
        else gemm_std<EpiPlainT<true>, false>(lds, (const bf16_t*)A, (const bf16_t*)Bt, MT, 1024, 1024, EpiPlainT<true>{O, 1024, 4, nullptr, 0}, 0);
    } else if (FP8_MIX && (which == 2 || kind == 1)) {
        if (f8) gemm_std<EpiPlainT<true>, true>(lds, (const bf16_t*)A, (const bf16_t*)Bt, MT, 1024, 512, EpiPlainT<true>{O, 1024, 4, nullptr, 0}, 0);
        else gemm_std<EpiPlainT<true>, false>(lds, (const bf16_t*)A, (const bf16_t*)Bt, MT, 1024, 1024, EpiPlainT<true>{O, 1024, 4, nullptr, 0}, 0);
    } else if (f8) gemm_std<EpiPlain, true>(lds, (const bf16_t*)A, (const bf16_t*)Bt, MT, 1024, 512, EpiPlain{O, 1024, 4, nullptr, 0}, 0);
    else gemm_std<EpiPlain, false>(lds, (const bf16_t*)A, (const bf16_t*)Bt, MT, 1024, 1024, EpiPlain{O, 1024, 4, nullptr, 0}, 0); }
PHASE_FN f_s5_glu(LAS unsigned char* lds) { KARGS();
#if FP8_GLU
    gemm_std<EpiGlu<0, FP8_MIX != 0>, true>(lds, (const bf16_t*)(ws + WS_T0), (const bf16_t*)(ws + WS_WGLU), MT, 2048, 512, EpiGlu<0, FP8_MIX != 0>{(bf16_t*)(ws + WS_MIX), nullptr}, 0); }
#else
    gemm_std(lds, (const bf16_t*)(ws + WS_T0), (const bf16_t*)(ws + WS_WGLU), MT, 2048, 1024, EpiGlu<0>{(bf16_t*)(ws + WS_MIX), nullptr}, 0); }
#endif
PHASE_FN f_ln(LAS unsigned char* lds, int layer, int which, bool use_mix, bool dry = false) { KARGS(); ln_phase<0>(p, lds, layer, which, (const bf16_t*)(ws + WS_MIX), false, use_mix, (which == 1 || FP8_Q) && !dry ? ws + WS_H8 : nullptr, dry, FP8_MIX && (which == 1 || (layer % 3) != 0) && (FP8_GLU || (layer % 3) != 2), which == 1 && !dry); }
PHASE_FN f_cross(LAS unsigned char* lds) { KARGS(); cross_attn_phase(p, lds); }
PHASE_FN f_dbg(LAS unsigned char* lds) { KARGS(); dbg_scan_phase(p); }
PHASE_FN f_router(LAS unsigned char* lds, int layer) { KARGS(); router_phase(p, lds, layer); }
PHASE_FN f_moe_up(LAS unsigned char* lds, int layer) { KARGS(); moe_tables(p, lds, layer);
    LAS unsigned short* rowidx = (LAS unsigned short*)(lds + ROWIDX_OFF);
    MoeOrder S{l_gdim(), l_bid(), 8, ((LAS int*)(lds + MISC_OFF + 64))[0], (const LAS unsigned char*)(lds + MISC_OFF + 512), (const LAS int*)(lds + MISC_OFF + 64), (const int*)(ws + WS_LIST), 1024u, rowidx};
    { const int t = l_tid(), kh = t >> 8, r = t & 255;
      int tokv[17];
      pg8::Unit u0; S.next(0, u0);
#pragma unroll
      for (int j = 0; j < 17; ++j) { const int k = 2 * j + kh; pg8::Unit u; const bool ok = k < 33 && S.next(k, u); if (!ok) u = u0;
          int e, i0, cn; S.unit_rows(u, e, i0, cn); tokv[j] = S.row_tok(e, i0 + r, cn); }
#pragma unroll
      for (int j = 0; j < 17; ++j) { const int k = 2 * j + kh; if (k < 33) rowidx[k * 256 + r] = (unsigned short)tokv[j]; }
      __syncthreads(); }
    pg8::Gemm g{(const bf16_t*)(ws + WS_H8), (const bf16_t*)(ws + WS_W1 + (size_t)layer * 32 * 2048 * 1024), NSLOT, 32 * 2048, 512};
    pg8::gemm_phase_gather<EpiGlu<1, true>, MoeOrder, true, true, true>(lds, g, S, EpiGlu<1, true>{(bf16_t*)(ws + WS_BIG + BM_ACT), (const bf16_t*)(ws + WS_B1H) + (size_t)layer * 32 * 2048}); }
PHASE_FN f_moe_down(LAS unsigned char* lds, int layer) { KARGS(); if (p.hi - p.lo == 1) moe_tables(p, lds, layer);
    MoeOrder S{l_gdim(), l_bid(), 4, ((LAS int*)(lds + MISC_OFF + 64))[0], (const LAS unsigned char*)(lds + MISC_OFF + 512), (const LAS int*)(lds + MISC_OFF + 64), (const int*)(ws + WS_LIST), 1024u, nullptr};
    pg8::Gemm g{(const bf16_t*)(ws + WS_BIG + BM_ACT), (const bf16_t*)(ws + WS_W2 + (size_t)layer * 32 * 1024 * 1024), NSLOT, 32 * 1024, 512};
    pg8::gemm_phase<EpiPlainT<true>, MoeOrder, true, true, true>(lds, g, S, EpiPlainT<true>{(bf16_t*)(ws + WS_BIG + BM_YS), 1024, 4, nullptr, 0}); }
PHASE_FN f_ln_moe(LAS unsigned char* lds, int layer) { KARGS(); if (!DBG_NO_MOE && p.hi - p.lo == 1) moe_tables(p, lds, layer); ln_phase<1>(p, lds, layer, 2, (const bf16_t*)(ws + WS_BIG + BM_YS), layer == DEPTH - 1, true, ((FP8_DIL && layer == 0) || ((FP8_HGRN || FP8_HGRN_G || FP8_HGRN_QI) && layer == 2)) ? ws + WS_H8 : nullptr); }

__global__ void __launch_bounds__(512, 2) mk_fwd(Params p) {
    extern __shared__ __attribute__((aligned(16))) unsigned char lds_raw[];
    LAS unsigned char* lds0 = (LAS unsigned char*)lds_raw; LAS unsigned char* lds = l_lds(lds0);
    for (int u = l_tid(); u < (LDS_BYTES - MISC_OFF) / 4; u += 512) ((LAS unsigned*)(lds + MISC_OFF))[u] = 0u;
    __syncthreads();
    XcdBarrier bar = xcd_barrier_post((unsigned*)(p.ws + CTL_BAR) + (size_t)p.li * XCD_BAR_WORDS, (volatile LAS unsigned*)(lds + MISC_OFF));
    const int lo = p.lo, hi = p.hi; int ph = 0;
#define PH(call) do { if (ph >= lo && ph < hi) { LAS unsigned char* lds = l_lds(lds0); call; if (ph + 1 < hi) { grid_barrier(bar); if (DBG_REPEAT & (1 << 20)) grid_barrier(bar); } } ++ph; } while (0)
#ifndef DBG_REPEAT
#define DBG_REPEAT 0
#endif
#define PHR(bit, call) PH(call; if (DBG_REPEAT & (1 << (bit))) { call; })
    PHR(0, f_prologue(lds));
    PH(f_memkv(lds));
#define LAYER_BODY(layer) do { constexpr int kind = (layer) % 3, j = (layer) / 3; \
        if (kind == 0) { PH(f_hgrn_in(lds, j); if (DBG_REPEAT & 2) f_hgrn_in(lds, j); if (DBG_REPEAT & (1 << 21)) f_hgrn_in_light(lds, j)); PHR(2, f_hgrn_scan(lds, j)); } \
        else if (kind == 1) { PHR(3, f_dil_in(lds)); PHR(4, f_dil_attn(lds)); } \
        else { PHR(6, f_s5(lds)); } \
        if (kind != 2) PHR(7, f_gemm_plain(lds, 0, layer)); else PHR(8, f_s5_glu(lds)); \
        PH(f_ln(lds, layer, 0, true); if (DBG_REPEAT & (1 << 9)) f_ln(lds, layer, 0, true, true)); \
        PHR(7, f_gemm_plain(lds, 1, layer)); \
        PHR(10, f_cross(lds)); \
        PHR(7, f_gemm_plain(lds, 2, layer)); \
        PH(f_ln(lds, layer, 1, true); if (DBG_REPEAT & (1 << 9)) f_ln(lds, layer, 1, true, true); wg_seam(); f_router(lds, layer));   \
        PHR(13, f_moe_up(lds, layer)); \
        PHR(14, f_moe_down(lds, layer)); \
        PH(f_ln_moe(lds, layer)); } while (0)
    LAYER_BODY(0); LAYER_BODY(1); LAYER_BODY(2); LAYER_BODY(3);
#undef LAYER_BODY
#undef PH
}

#ifndef MK_SINGLE
#define MK_SINGLE 1
#endif
extern "C" void kernel_launch(void* const* d_in, const int* in_sizes, int n_in, void* d_out, int out_size, void* d_ws, size_t ws_size, hipStream_t stream) {
    static int grid = 0;
    if (grid == 0) {
        if (n_in != 29 || out_size != MT * DM || ws_size < WS_END) { fprintf(stderr, "kernel_launch: unexpected shapes (n_in %d, out %d, ws %zu < %zu)\n", n_in, out_size, ws_size, (size_t)WS_END); grid = -1; return; }
        int dev = 0, cus = 0, per_cu = 0;
        if (hipGetDevice(&dev) != hipSuccess || hipDeviceGetAttribute(&cus, hipDeviceAttributeMultiprocessorCount, dev) != hipSuccess) { grid = -1; return; }
        if (hipFuncSetAttribute((const void*)mk_fwd, hipFuncAttributeMaxDynamicSharedMemorySize, LDS_BYTES) != hipSuccess) { fprintf(stderr, "kernel_launch: hipFuncSetAttribute failed\n"); grid = -1; return; }
        if (hipOccupancyMaxActiveBlocksPerMultiprocessor(&per_cu, (const void*)mk_fwd, 512, LDS_BYTES) != hipSuccess || per_cu < 1) { fprintf(stderr, "kernel_launch: occupancy query says %d\n", per_cu); }
        (void)hipGetLastError();
        grid = cus;
    }
    if (grid < 0) return;
    (void)hipMemsetAsync((char*)d_ws + WS_CTL, 0, CTL_BYTES, stream);
    Params p{};
    for (int i = 0; i < 29; ++i) p.in[i] = (const float*)d_in[i];
    p.pos = (const int*)d_in[2]; p.out = (float*)d_out; p.ws = (unsigned char*)d_ws; p.pad = 0;
#if MK_SINGLE
    p.lo = 0; p.hi = N_PHASES; p.li = 0;
    hipLaunchKernelGGL(mk_fwd, dim3(grid), dim3(512), LDS_BYTES, stream, p);
#else
    for (int ph = 0; ph < N_PHASES; ++ph) { p.lo = ph; p.hi = ph + 1; p.li = 0; hipLaunchKernelGGL(mk_fwd, dim3(grid), dim3(512), LDS_BYTES, stream, p); }
#endif
    const hipError_t le = hipPeekAtLastError();
    if (le != hipSuccess) fprintf(stderr, "kernel_launch: launch failed: %s\n", hipGetErrorName(le));
}
```
